# Optimizing an MI355X kernel written in HIP

```python
import jax, jax.numpy as jnp
from jax import lax
import numpy as np

D_MODEL = 1024
BATCH = 8
SEQ = 4096
DEPTH = 4

HEAD_DIM = D_MODEL // 8
ATTN_GROUPS = ((128, 1), (512, 4), (2048, 16))
HEADS_PER_GROUP = 4
N_ATTN_HEADS = HEADS_PER_GROUP * len(ATTN_GROUPS)
ATTN_WIDTH = N_ATTN_HEADS * HEAD_DIM
ATTN_OUT_WIDTH = HEADS_PER_GROUP * HEAD_DIM
N_BUCKETS = 32
REL_MAX_DISTANCE = 1024
FOURIER_GROUPS = 4
FOURIER_GROUP_DIM = D_MODEL // 8
FOURIER_WIDTH = FOURIER_GROUPS * FOURIER_GROUP_DIM
POOL_WINDOWS = (2, 4, 8, 16)
POOL_GROUP_DIM = D_MODEL // 8
POOL_WIDTH = len(POOL_WINDOWS) * POOL_GROUP_DIM
N_BRANCHES = 3
IN_COLS = 3 * ATTN_WIDTH + FOURIER_WIDTH + POOL_WIDTH + N_BRANCHES * D_MODEL
FFN_DIM = 2816
N_EXPERTS = 8
TOP_K = 2
EXPERT_DIM = 3584
EXPERT_BLOCK = 512
RMS_EPS = 1e-6
NEG_INF = -1e30

kernel_name = 'hybrid_dilated_fourier_pool_moe_encoder'


def _rms_norm(x, g):
    x32 = x.astype(jnp.float32)
    y = x32 * lax.rsqrt(jnp.mean(x32 * x32, axis=-1, keepdims=True) + RMS_EPS)
    return (y * g.astype(jnp.float32)).astype(x.dtype)


def _t5_bucket(rel):
    half = N_BUCKETS // 2
    ret = (rel > 0).astype(np.int64) * half
    n = np.abs(rel)
    max_exact = half // 2
    large = max_exact + (np.log(np.maximum(n, 1) / max_exact) / np.log(REL_MAX_DISTANCE / max_exact)
                         * (half - max_exact)).astype(np.int64)
    large = np.minimum(large, half - 1)
    return (ret + np.where(n < max_exact, n, large)).astype(np.int32)


def _dilated_window_attention(q, k, v, bias_table, window, dilation):
    B, S, H, Dh = q.shape
    P = window // (2 * dilation)
    L = S // dilation
    nb = -(-L // P)
    Lp = nb * P
    BB = B * dilation

    def to_sub(t):
        t = t.reshape(B, L, dilation, H, Dh).transpose(0, 2, 3, 1, 4).reshape(BB, H, L, Dh)
        return jnp.pad(t, ((0, 0), (0, 0), (0, Lp - L), (0, 0)))

    def to_bands(t):
        t = jnp.pad(t, ((0, 0), (0, 0), (P, P), (0, 0))).reshape(BB, H, nb + 2, P, Dh)
        return jnp.concatenate([t[:, :, :-2], t[:, :, 1:-1], t[:, :, 2:]], axis=3)

    qs = to_sub(q).reshape(BB, H, nb, P, Dh)
    kb = to_bands(to_sub(k))
    vb = to_bands(to_sub(v))

    r = np.arange(P)[:, None]
    c = np.arange(3 * P)[None, :]
    off = c - P - r
    key_sub = np.arange(nb)[:, None, None] * P + c[None] - P
    mask = (np.abs(off) <= P)[None] & (key_sub >= 0) & (key_sub < L)
    bias = bias_table.astype(jnp.float32)[_t5_bucket(off * dilation)].transpose(2, 0, 1)

    s = jnp.einsum('bhnqd,bhnkd->bhnqk', qs, kb).astype(jnp.float32) * (Dh ** -0.5)
    s = jnp.where(mask[None, None], s + bias[None, :, None], NEG_INF)
    m = jnp.max(s, axis=-1, keepdims=True)
    p = jnp.exp(s - m)
    den = jnp.sum(p, axis=-1)
    o = jnp.einsum('bhnqk,bhnkd->bhnqd', p.astype(v.dtype), vb) / den[..., None].astype(v.dtype)
    lse = m[..., 0] + jnp.log(den)

    o = o.reshape(BB, H, Lp, Dh)[:, :, :L].reshape(B, dilation, H, L, Dh)
    o = o.transpose(0, 3, 1, 2, 4).reshape(B, S, H, Dh)
    lse = lse.reshape(BB, H, Lp)[:, :, :L].reshape(B, dilation, H, L).transpose(0, 3, 1, 2).reshape(B, S, H)
    return o, lse


def _fourier_mix(u):
    B, S, _ = u.shape
    u32 = u.astype(jnp.float32).reshape(B, S, FOURIER_GROUPS, FOURIER_GROUP_DIM)
    f = jnp.fft.fft2(u32, axes=(1, 3), norm='ortho').real
    return f.reshape(B, S, FOURIER_WIDTH).astype(u.dtype)


def _multiscale_pool(u, pool_w, pool_scale):
    B, S, _ = u.shape
    u32 = u.astype(jnp.float32)
    csum = jnp.concatenate([jnp.zeros((B, 1, POOL_WIDTH), jnp.float32), jnp.cumsum(u32, axis=1)], axis=1)
    pos = np.arange(S)
    outs = []
    for g, w in enumerate(POOL_WINDOWS):
        cols = slice(g * POOL_GROUP_DIM, (g + 1) * POOL_GROUP_DIM)
        lo = np.maximum(pos - w // 2, 0)
        hi = np.minimum(pos + w // 2 - 1, S - 1)
        cnt = (hi - lo + 1).astype(np.float32)
        cg = csum[:, :, cols]
        mean = (cg[:, hi + 1] - cg[:, lo]) / cnt[None, :, None]
        outs.append(mean - u32[:, :, cols])
    d = jnp.stack(outs, axis=2).astype(u.dtype)
    y = jnp.einsum('bsgc,gcd->bsgd', d, pool_w).reshape(B, S, POOL_WIDTH)
    return y * pool_scale


def _hybrid_mixer(h, w_in, q_g, k_g, rel_bias, pool_w, pool_scale, w_ba, w_bf, w_bp, w_out):
    B, S, _ = h.shape
    z = h @ w_in
    splits = np.cumsum([ATTN_WIDTH, ATTN_WIDTH, ATTN_WIDTH, FOURIER_WIDTH, POOL_WIDTH]).tolist()
    q, k, v, uf, up, gl = jnp.split(z, splits, axis=-1)
    q = _rms_norm(q.reshape(B, S, N_ATTN_HEADS, HEAD_DIM), q_g)
    k = _rms_norm(k.reshape(B, S, N_ATTN_HEADS, HEAD_DIM), k_g)
    v = v.reshape(B, S, N_ATTN_HEADS, HEAD_DIM)

    outs, lses = [], []
    for g, (window, dilation) in enumerate(ATTN_GROUPS):
        hs = slice(g * HEADS_PER_GROUP, (g + 1) * HEADS_PER_GROUP)
        o, l = _dilated_window_attention(q[:, :, hs], k[:, :, hs], v[:, :, hs], rel_bias[:, hs], window, dilation)
        outs.append(o)
        lses.append(l)
    wts = jax.nn.softmax(jnp.stack(lses, axis=0), axis=0).astype(h.dtype)
    attn = jnp.sum(wts[..., None] * jnp.stack(outs, axis=0), axis=0).reshape(B, S, ATTN_OUT_WIDTH)

    four = _fourier_mix(uf)
    pool = _multiscale_pool(up, pool_w, pool_scale)

    gates = jax.nn.sigmoid(gl.astype(jnp.float32)).astype(h.dtype).reshape(B, S, N_BRANCHES, D_MODEL)
    merged = (gates[:, :, 0] * (attn @ w_ba) + gates[:, :, 1] * (four @ w_bf) + gates[:, :, 2] * (pool @ w_bp))
    return merged @ w_out


def _swiglu(h, w1, w3, w2):
    return (jax.nn.silu(h @ w1) * (h @ w3)) @ w2


def _moe_swiglu(h, router_w, router_b, w1, w3, w2):
    B, S, D = h.shape
    N = B * S
    NK = N * TOP_K
    t = h.reshape(N, D)
    logits = t.astype(jnp.float32) @ router_w.astype(jnp.float32) + router_b.astype(jnp.float32)
    top_val, top_idx = lax.top_k(logits, TOP_K)
    gates = jax.nn.softmax(top_val, axis=-1)
    e = top_idx.reshape(-1).astype(jnp.int32)
    order = jnp.argsort(e)
    sorted_e = e[order]
    counts = jnp.bincount(e, length=N_EXPERTS).astype(jnp.int32)
    padded = ((counts + EXPERT_BLOCK - 1) // EXPERT_BLOCK) * EXPERT_BLOCK
    start = jnp.cumsum(counts) - counts
    pend = jnp.cumsum(padded)
    pstart = pend - padded
    rank = jnp.arange(NK, dtype=jnp.int32) - start[sorted_e]
    dest_sorted = pstart[sorted_e] + rank
    n_blocks = -(-NK // EXPERT_BLOCK) + N_EXPERTS
    R = n_blocks * EXPERT_BLOCK
    row_token = jnp.full((R,), N, jnp.int32).at[dest_sorted].set((order // TOP_K).astype(jnp.int32))
    t_pad = jnp.concatenate([t, jnp.zeros((1, D), t.dtype)], axis=0)
    xs = t_pad[row_token].reshape(n_blocks, EXPERT_BLOCK, D)
    blk_start = jnp.arange(n_blocks, dtype=jnp.int32) * EXPERT_BLOCK
    blk_e = jnp.minimum(jnp.searchsorted(pend, blk_start, side='right'), N_EXPERTS - 1)

    def expert_block(args):
        xb, eb = args
        return (jax.nn.silu(xb @ w1[eb]) * (xb @ w3[eb])) @ w2[eb]

    ys = lax.map(expert_block, (xs, blk_e)).reshape(R, D)
    dest = jnp.zeros((NK,), jnp.int32).at[order].set(dest_sorted)
    y = jnp.sum(ys[dest].reshape(N, TOP_K, D) * gates[..., None].astype(ys.dtype), axis=1)
    return y.reshape(B, S, D)


def setup_inputs(seed: int = 0) -> dict:
    key = jax.random.key(seed)
    ks = jax.random.split(key, 22)
    n_dense = (DEPTH + 1) // 2
    n_moe = DEPTH // 2

    def nrm(k, shape, scale):
        return jax.random.normal(k, shape, jnp.float32) * scale

    def gain(k, shape, s=0.02):
        return 1.0 + s * jax.random.normal(k, shape, jnp.float32)

    return {
        'x': nrm(ks[0], (BATCH, SEQ, D_MODEL), 1.0),
        'norm_mix_g': gain(ks[1], (DEPTH, D_MODEL)),
        'w_in': nrm(ks[2], (DEPTH, D_MODEL, IN_COLS), D_MODEL ** -0.5),
        'q_norm_g': gain(ks[3], (DEPTH, HEAD_DIM)),
        'k_norm_g': gain(ks[4], (DEPTH, HEAD_DIM)),
        'rel_bias': nrm(ks[5], (N_BUCKETS, N_ATTN_HEADS), 0.5),
        'pool_w': nrm(ks[6], (DEPTH, len(POOL_WINDOWS), POOL_GROUP_DIM, POOL_GROUP_DIM), POOL_GROUP_DIM ** -0.5),
        'pool_scale': gain(ks[7], (DEPTH, POOL_WIDTH), 0.1),
        'w_branch_attn': nrm(ks[8], (DEPTH, ATTN_OUT_WIDTH, D_MODEL), ATTN_OUT_WIDTH ** -0.5),
        'w_branch_fourier': nrm(ks[9], (DEPTH, FOURIER_WIDTH, D_MODEL), FOURIER_WIDTH ** -0.5),
        'w_branch_pool': nrm(ks[10], (DEPTH, POOL_WIDTH, D_MODEL), POOL_WIDTH ** -0.5),
        'w_out': nrm(ks[11], (DEPTH, D_MODEL, D_MODEL), D_MODEL ** -0.5),
        'norm_ffn_g': gain(ks[12], (DEPTH, D_MODEL)),
        'ffn_w1': nrm(ks[13], (n_dense, D_MODEL, FFN_DIM), D_MODEL ** -0.5),
        'ffn_w3': nrm(ks[14], (n_dense, D_MODEL, FFN_DIM), D_MODEL ** -0.5),
        'ffn_w2': nrm(ks[15], (n_dense, FFN_DIM, D_MODEL), FFN_DIM ** -0.5),
        'router_w': nrm(ks[16], (n_moe, D_MODEL, N_EXPERTS), D_MODEL ** -0.5),
        'router_b': nrm(ks[17], (n_moe, N_EXPERTS), 0.01),
        'moe_w1': nrm(ks[18], (n_moe, N_EXPERTS, D_MODEL, EXPERT_DIM), D_MODEL ** -0.5),
        'moe_w3': nrm(ks[19], (n_moe, N_EXPERTS, D_MODEL, EXPERT_DIM), D_MODEL ** -0.5),
        'moe_w2': nrm(ks[20], (n_moe, N_EXPERTS, EXPERT_DIM, D_MODEL), EXPERT_DIM ** -0.5),
    }


def reference(x, norm_mix_g, w_in, q_norm_g, k_norm_g, rel_bias, pool_w, pool_scale, w_branch_attn,
              w_branch_fourier, w_branch_pool, w_out, norm_ffn_g, ffn_w1, ffn_w3, ffn_w2,
              router_w, router_b, moe_w1, moe_w3, moe_w2):
    for layer in range(DEPTH):
        h = _rms_norm(x, norm_mix_g[layer])
        x = x + _hybrid_mixer(h, w_in[layer], q_norm_g[layer], k_norm_g[layer], rel_bias,
                              pool_w[layer], pool_scale[layer], w_branch_attn[layer],
                              w_branch_fourier[layer], w_branch_pool[layer], w_out[layer])
        h = _rms_norm(x, norm_ffn_g[layer])
        j = layer // 2
        if layer % 2 == 0:
            x = x + _swiglu(h, ffn_w1[j], ffn_w3[j], ffn_w2[j])
        else:
            x = x + _moe_swiglu(h, router_w[j], router_b[j], moe_w1[j], moe_w3[j], moe_w2[j])
    return x
```

```cpp
#include <hip/hip_runtime.h>
#include <cstdio>
#include <cstdint>
#include <cmath>

#ifndef MOE_F8_MASK
#define MOE_F8_MASK 3
#endif
#ifndef DENSE_UP8_MASK
#define DENSE_UP8_MASK 3
#endif
#ifndef DENSE_F8_MASK
#define DENSE_F8_MASK 2
#endif
#define F8_SW 64.0f
#define F8_SACT 8.0f
#define DFT_SA 16384.0f
#define DFT_SY 16.0f
#ifndef PROL_A
#define PROL_A 0
#define PROL_C 0
#endif
#ifndef ONE_LAUNCH
#define ONE_LAUNCH 1
#endif

#define LAS __attribute__((address_space(3)))
#define GAS __attribute__((address_space(1)))
typedef unsigned short bf16_t;
typedef short bf16x8 __attribute__((ext_vector_type(8)));
typedef short s16x4 __attribute__((ext_vector_type(4)));
typedef float f32x4 __attribute__((ext_vector_type(4)));
typedef float f32x2 __attribute__((ext_vector_type(2)));
typedef unsigned u32x4 __attribute__((ext_vector_type(4)));
typedef unsigned u32x2 __attribute__((ext_vector_type(2)));
typedef __bf16 bf16x2_t __attribute__((ext_vector_type(2)));
typedef int i32x8 __attribute__((ext_vector_type(8)));
typedef int i32x4 __attribute__((ext_vector_type(4)));

constexpr int DM = 1024, NTOK = 32768, SEQ = 4096, NBATCH = 8, DEPTH = 4;
constexpr int SRC_IN = 8704;
constexpr int INW = 9216;
constexpr int QKVW = 4608;
constexpr int FF = 2816, NE = 8, ED = 3584;
constexpr float RMS_EPS = 1e-6f;
constexpr int NWAVES = 8, NTHR = 512;

constexpr size_t MiB = 1u << 20;
constexpr size_t WS_CTL = 0, CTL_ZERO_BYTES = 1 * MiB;
constexpr size_t WS_RINFO = 1 * MiB;
constexpr size_t WS_DS = 8 * MiB;
constexpr size_t WS_T2048 = 44 * MiB;
constexpr size_t WS_WIN = 72 * MiB;
constexpr size_t WIN_SLOT = 18 * MiB, WIN_SW = 8 * MiB, WIN_F = 10 * MiB;
constexpr size_t WS_WB = 144 * MiB;
constexpr size_t WS_WO = 156 * MiB;
constexpr size_t W13_SLOT = 11 * MiB, W13_SW = 6 * MiB;
constexpr size_t WS_W13 = 164 * MiB;
constexpr size_t WS_W2 = 186 * MiB;
constexpr size_t WS_H = 200 * MiB;
constexpr size_t H_SH = 32 * MiB;
constexpr size_t WS_QKV = 264 * MiB;
constexpr size_t WS_HF = 552 * MiB;
constexpr size_t WS_UP = 616 * MiB;
constexpr size_t WS_GATES = 648 * MiB;
constexpr size_t WS_OG = 840 * MiB;
constexpr size_t WS_YT = 936 * MiB;
constexpr size_t WS_PD = 1000 * MiB;
constexpr size_t WS_LSE = 1032 * MiB;
constexpr size_t WS_END = 1034 * MiB;
constexpr size_t WS_ATTN = 264 * MiB;
constexpr size_t WS_FOUR = 296 * MiB;
constexpr size_t WS_MERGED = 328 * MiB;
constexpr size_t WS_SLAB = 456 * MiB;
constexpr size_t WS_ACT = 264 * MiB;
constexpr size_t WS_XB = 744 * MiB;
constexpr size_t WS_WM2 = 838 * MiB;
constexpr size_t WS_Y1 = 894 * MiB;
static_assert(WS_Y1 + (size_t)NTOK * DM * 2 <= WS_END, "ws map");
constexpr int CW_TMO = 0;
constexpr int CW_BAR = 4096;
constexpr int CW_GCNT = 8192;
constexpr int CW_GRAN = 16384;
constexpr int CW_TAIL = 12288;
constexpr int MOE_KS = 7, MOE_TAIL_MAX = 64;

constexpr int LDS_BYTES = 147456;
constexpr int AT_K = 0, AT_V = 65536;
constexpr int BT_OFF = 135168;
constexpr int MISC_OFF = 142848;

#define LDS_WAIT() asm volatile("s_waitcnt lgkmcnt(0)" ::: "memory")
#define VM_WAIT() asm volatile("s_waitcnt vmcnt(0)" ::: "memory")
__device__ __forceinline__ unsigned pk2(float lo, float hi) { f32x2 v = {lo, hi}; bf16x2_t r = __builtin_convertvector(v, bf16x2_t); return __builtin_bit_cast(unsigned, r); }
__device__ __forceinline__ float clamp8(float v) { return __builtin_amdgcn_fmed3f(v, -448.0f, 448.0f); }
__device__ __forceinline__ unsigned pk8x4(float a, float b, float c, float d) {
    int p = __builtin_amdgcn_cvt_pk_fp8_f32(clamp8(a), clamp8(b), 0, false); p = __builtin_amdgcn_cvt_pk_fp8_f32(clamp8(c), clamp8(d), p, true); return (unsigned)p; }
__device__ __forceinline__ unsigned pk8x4_nc(float a, float b, float c, float d) {
    int p = __builtin_amdgcn_cvt_pk_fp8_f32(a, b, 0, false); p = __builtin_amdgcn_cvt_pk_fp8_f32(c, d, p, true); return (unsigned)p; }
__device__ __forceinline__ float bf_lo(unsigned u) { return __uint_as_float(u << 16); }
__device__ __forceinline__ float bf_hi(unsigned u) { return __uint_as_float(u & 0xffff0000u); }
template <bool BF> __device__ __forceinline__ f32x4 ldx4(const void* p, size_t i4) {
    if constexpr (BF) { const u32x2 w = ((const u32x2*)p)[i4]; return (f32x4){bf_lo(w.x), bf_hi(w.x), bf_lo(w.y), bf_hi(w.y)}; }
    else return ((const f32x4*)p)[i4];
}
template <bool BF> __device__ __forceinline__ void ldx8(const void* p, size_t i8, f32x4& a, f32x4& b) {
    if constexpr (BF) { const u32x4 w = ((const u32x4*)p)[i8]; a = (f32x4){bf_lo(w.x), bf_hi(w.x), bf_lo(w.y), bf_hi(w.y)}; b = (f32x4){bf_lo(w.z), bf_hi(w.z), bf_lo(w.w), bf_hi(w.w)}; }
    else { a = ((const f32x4*)p)[2 * i8]; b = ((const f32x4*)p)[2 * i8 + 1]; }
}
__device__ __forceinline__ void stx8(bf16_t* p, size_t i8, const f32x4 a, const f32x4 b) { u32x4 w; w.x = pk2(a.x, a.y); w.y = pk2(a.z, a.w); w.z = pk2(b.x, b.y); w.w = pk2(b.z, b.w); ((u32x4*)p)[i8] = w; }
__device__ __forceinline__ void stx4(bf16_t* p, size_t i4, const f32x4 v) { u32x2 w; w.x = pk2(v.x, v.y); w.y = pk2(v.z, v.w); ((u32x2*)p)[i4] = w; }
__device__ __forceinline__ float wave_sum(float v) {
#pragma unroll
    for (int o = 1; o < 64; o <<= 1) v += __shfl_xor(v, o);
    return v;
}
__device__ __forceinline__ float fast_exp(float x) { return __builtin_amdgcn_exp2f(x * 1.4426950408889634f); }
__device__ __forceinline__ float sigmoidf_(float x) { return __builtin_amdgcn_rcpf(1.0f + fast_exp(-x)); }

#define XB_TMO      128
#define XB_XCNT(j)  (256  + 64 * (j))
#define XB_XSUB(j)  (1280 + 64 * (j))
#define XB_XGEN(j)  (2304 + 64 * (j))
#define XB_TOP      3328
#define XB_TOPGEN   3392
#define XCD_BAR_WORDS 3456
#define XB_SPIN_CAP (1u << 18)
__device__ __forceinline__ unsigned xb_ld(unsigned* p)              { return __hip_atomic_load(p, __ATOMIC_RELAXED, __HIP_MEMORY_SCOPE_AGENT); }
__device__ __forceinline__ unsigned xb_add(unsigned* p, unsigned v) { return __hip_atomic_fetch_add(p, v, __ATOMIC_RELAXED, __HIP_MEMORY_SCOPE_AGENT); }
__device__ __forceinline__ unsigned xb_xcc_id() { return (unsigned)__builtin_amdgcn_s_getreg((3 << 11) | 20) & 0xFu; }
#define XB_SPIN(cond, bar) do { unsigned _sp = 0; while (cond) { __builtin_amdgcn_s_sleep(1); \
    if ((++_sp & 255u) == 0u) { if (xb_ld(&(bar)[XB_TMO])) break; if (_sp > XB_SPIN_CAP) { atomicAdd(&(bar)[XB_TMO], 1u); break; } } } } while (0)
struct XcdBarrier { unsigned* bar; unsigned x; volatile LAS unsigned* st; };
__device__ __forceinline__ XcdBarrier xcd_barrier_post(unsigned* bar, volatile LAS unsigned* st) {
    XcdBarrier b; b.bar = bar; b.x = xb_xcc_id(); b.st = st;
    if (threadIdx.x == 0) (void)xb_add(&bar[XB_XCNT(b.x)], 1u);
    return b;
}
__device__ __forceinline__ void xcd_barrier_complete(unsigned* bar, unsigned x, unsigned& nloc, unsigned& nx) {
    const unsigned G = gridDim.x * gridDim.y * gridDim.z;
    unsigned sum, cnt, mine, sp = 0u;
    for (;;) {
        sum = 0u; cnt = 0u; mine = 0u;
#pragma unroll
        for (unsigned j = 0; j < 16; ++j) { const unsigned c = xb_ld(&bar[XB_XCNT(j)]); sum += c; cnt += (c > 0u) ? 1u : 0u; mine = (j == x) ? c : mine; }
        if (sum == G) break;
        __builtin_amdgcn_s_sleep(1);
        if ((++sp & 255u) == 0u) { if (xb_ld(&bar[XB_TMO])) break; if (sp > XB_SPIN_CAP) { atomicAdd(&bar[XB_TMO], 1u); break; } }
    }
    nloc = mine > 0u ? mine : 1u; nx = cnt > 0u ? cnt : 1u;
}
__device__ __forceinline__ void xcd_barrier(const XcdBarrier& b) {
    asm volatile("s_waitcnt vmcnt(0)" ::: "memory");
    __syncthreads();
    if (threadIdx.x == 0) {
        unsigned* bar = b.bar;
        __builtin_amdgcn_s_waitcnt(0);
        asm volatile("buffer_inv sc1" ::: "memory");
        unsigned nloc = b.st[0], nx = b.st[1];
        if (nloc == 0u) { xcd_barrier_complete(bar, b.x, nloc, nx); b.st[0] = nloc; b.st[1] = nx; }
        const unsigned old = xb_add(&bar[XB_XSUB(b.x)], 1u);
        const unsigned gen = old / nloc;
        if (old + 1u == (gen + 1u) * nloc) {
            __builtin_amdgcn_fence(__ATOMIC_RELEASE, "agent");
            asm volatile("s_waitcnt vmcnt(0)" ::: "memory");
            const unsigned og = xb_add(&bar[XB_TOP], 1u);
            const unsigned tg = og / nx;
            if (og + 1u == (tg + 1u) * nx) xb_add(&bar[XB_TOPGEN], 1u);
            else XB_SPIN(xb_ld(&bar[XB_TOPGEN]) == tg, bar);
            asm volatile("" ::: "memory");
            xb_add(&bar[XB_XGEN(b.x)], 1u);
            asm volatile("s_waitcnt vmcnt(0)" ::: "memory");
        } else {
            if (old == gen * nloc) asm volatile("buffer_wbl2 sc1" ::: "memory");
            XB_SPIN(xb_ld(&bar[XB_XGEN(b.x)]) == gen, bar);
            asm volatile("s_waitcnt vmcnt(0)" ::: "memory");
        }
    }
    __syncthreads();
}

namespace pg8 {
constexpr int BM = 256, BK = 64, HALF = 128, HTB = HALF * BK * 2, STAGE_BYTES = 8 * HTB, NXCD = 8, WGM = 8;
__host__ __device__ __forceinline__ int lds_byte(int r, int c) { const int st = (r >> 4) * 2 + (c >> 5), rr = r & 15, cc = c & 31, ob = rr * 64 + cc * 2; return st * 1024 + (ob ^ (((ob >> 9) & 1) << 5)); }
__host__ __device__ __forceinline__ void stage_rc(int b, int& R, int& C) { const int st = b / 1024, sb = b % 1024, swz = sb ^ (((sb >> 9) & 1) << 5); R = (st >> 1) * 16 + swz / 64; C = (st & 1) * 32 + (swz % 64) / 2; }
__host__ __device__ __forceinline__ int perm32(int rho) { const int n = rho >> 4, i = rho & 15; return 8 * (i >> 2) + 4 * n + (i & 3); }

struct Unit { int pm, pn, e, lt; };
struct GemmP { int K, lda, ldb; };

struct TileMap {
    int nM, nN, nwg, G, c;
    __device__ __forceinline__ void init(int nM_, int nN_, int G_, int c_) { nM = nM_; nN = nN_; nwg = nM * nN; G = G_; c = c_; }
    __device__ __forceinline__ bool map(int i, int& pm, int& pn) const { return map_L((long)i * G + c, pm, pn); }
    __device__ __forceinline__ bool map_L(const long L, int& pm, int& pn) const {
        if (L >= nwg) return false;
        int wgid = (int)L; { const int q = nwg / NXCD, r = nwg % NXCD, xcd = wgid % NXCD, off = wgid / NXCD; wgid = (xcd < r ? xcd * (q + 1) : r * (q + 1) + (xcd - r) * q) + off; }
        const int nig = WGM * nN, gid = wgid / nig, fm = gid * WGM, gsz = (nM - fm) < WGM ? (nM - fm) : WGM;
        pm = fm + ((wgid % nig) % gsz); pn = (wgid % nig) / gsz; return true;
    }
};

template <class Epi, class Sched, int KDIM, int LDA, int LDB, bool SWAP = false, int QM = 0>
__device__ __forceinline__ void gemm_phase(LAS unsigned char* lds, const Sched& S, const Epi& E, const int tid) {
    constexpr bool GA = Sched::GATHER; constexpr bool ALIGN_EPI = true, SP2 = true; constexpr GemmP g{KDIM, LDA, LDB};
    const int wid = __builtin_amdgcn_readfirstlane(tid >> 6), lane = tid & 63, wr = wid >> 2, wc = wid & 3, fr = lane & 15, fq = lane >> 4;
    constexpr bool F8 = QM == 1, I8 = QM == 2; constexpr int ES = QM ? 1 : 2;
    const int nt = (g.K * ES) / (BK * 2);
    unsigned voffA[2][2], nvoffA[2][2], voffB[2]; int stR[2], stC[2];
#pragma unroll
    for (int i = 0; i < 2; ++i) { int R, C; stage_rc(tid * 16 + i * 8192, R, C); stR[i] = R; stC[i] = C; const int Rb = Epi::PERM ? ((R & ~31) + perm32(R & 31)) : R;
        voffA[0][i] = (unsigned)(R * g.lda * ES + C * 2); voffA[1][i] = voffA[0][i]; nvoffA[0][i] = voffA[0][i]; nvoffA[1][i] = voffA[0][i]; voffB[i] = (unsigned)(Rb * g.ldb * ES + C * 2); }
    const size_t kstep = (size_t)(BK * 2);
    const size_t hstepA = (size_t)HALF * g.lda * ES, hstepB = (size_t)HALF * g.ldb * ES;
    const unsigned ldsw = (unsigned)wid * 1024u;
    const int aoff = lds_byte(wr * 64 + fr, fq * 8), boff = lds_byte(wc * 32 + fr, fq * 8);
#define PG8_SA(b, h) (((b) * 2 + (h)) * HTB)
#define PG8_SB(b, h) ((4 + (b) * 2 + (h)) * HTB)
#define PG8_STAGE_B(bufoff, gbase) do { _Pragma("unroll") for (int _i = 0; _i < 2; ++_i) \
        __builtin_amdgcn_global_load_lds((const unsigned*)((const char*)(gbase) + voffB[_i]), (LAS unsigned*)(lds + (bufoff) + ldsw + _i * 8192), 16, 0, 0); } while (0)
#define PG8_STAGE_A(bufoff, h, gbase, vo) do { _Pragma("unroll") for (int _i = 0; _i < 2; ++_i) \
        __builtin_amdgcn_global_load_lds((const unsigned*)((const char*)(gbase) + (GA ? (size_t)0 : (size_t)(h) * hstepA) + (vo)[GA ? (h) : 0][_i]), (LAS unsigned*)(lds + (bufoff) + ldsw + _i * 8192), 16, 0, 0); } while (0)
#define PG8_LDA(dst, b, h) do { _Pragma("unroll") for (int m = 0; m < 4; ++m) _Pragma("unroll") for (int k = 0; k < 2; ++k) dst[m][k] = *(const LAS u32x4*)(lds + PG8_SA(b, h) + aoff + m * 2048 + k * 1024); } while (0)
#define PG8_LDB(dst, b, h) do { _Pragma("unroll") for (int n = 0; n < 2; ++n) _Pragma("unroll") for (int k = 0; k < 2; ++k) dst[n][k] = *(const LAS u32x4*)(lds + PG8_SB(b, h) + boff + n * 2048 + k * 1024); } while (0)
#define PG8_MMA(ai, bj, At, Bt) do { __builtin_amdgcn_s_setprio(1); if constexpr (F8) { _Pragma("unroll") for (int m = 0; m < 4; ++m) _Pragma("unroll") for (int n = 0; n < 2; ++n) \
        asm volatile("v_mfma_scale_f32_16x16x128_f8f6f4 %0, %1, %2, %0, %3, %3 op_sel_hi:[0,0,0]" : "+v"(acc[ai][bj][m][n]) \
            : "v"(__builtin_bit_cast(i32x8, __builtin_shufflevector(Bt[n][0], Bt[n][1], 0, 1, 2, 3, 4, 5, 6, 7))), "v"(__builtin_bit_cast(i32x8, __builtin_shufflevector(At[m][0], At[m][1], 0, 1, 2, 3, 4, 5, 6, 7))), "v"(0x7f7f7f7f)); } else { \
        _Pragma("unroll") for (int m = 0; m < 4; ++m) _Pragma("unroll") for (int n = 0; n < 2; ++n) _Pragma("unroll") for (int k = 0; k < 2; ++k) \
        acc[ai][bj][m][n] = I8 ? __builtin_bit_cast(f32x4, __builtin_amdgcn_mfma_i32_16x16x64_i8(__builtin_bit_cast(i32x4, Bt[n][k]), __builtin_bit_cast(i32x4, At[m][k]), __builtin_bit_cast(i32x4, acc[ai][bj][m][n]), 0, 0, 0)) : SWAP ? __builtin_amdgcn_mfma_f32_16x16x32_bf16(__builtin_bit_cast(bf16x8, At[m][k]), __builtin_bit_cast(bf16x8, Bt[n][k]), acc[ai][bj][m][n], 0, 0, 0) \
                                 : __builtin_amdgcn_mfma_f32_16x16x32_bf16(__builtin_bit_cast(bf16x8, Bt[n][k]), __builtin_bit_cast(bf16x8, At[m][k]), acc[ai][bj][m][n], 0, 0, 0); } __builtin_amdgcn_s_setprio(0); } while (0)
#define PG8_WAIT_V(n) asm volatile("s_waitcnt vmcnt(" #n ")" ::: "memory")
#define PG8_WAIT_V8E asm volatile("s_waitcnt vmcnt(%0)" :: "i"(8 + Epi::NST) : "memory")
#define PG8_WAIT_L(n) asm volatile("s_waitcnt lgkmcnt(" #n ")" ::: "memory")
#define PG8_BAR __builtin_amdgcn_s_barrier()
#define PG8_SCHED __builtin_amdgcn_sched_barrier(0)
#define PG8_SCHED8 do { if constexpr (F8) __builtin_amdgcn_sched_barrier(0); } while (0)
    Unit cur, nxt; int ui = 0;
    if (!S.next(0, cur)) return;
    f32x4 acc[2][2][4][2];
#pragma unroll
    for (int a = 0; a < 2; ++a)
#pragma unroll
        for (int b = 0; b < 2; ++b)
#pragma unroll
            for (int m = 0; m < 4; ++m)
#pragma unroll
                for (int n = 0; n < 2; ++n) acc[a][b][m][n] = (f32x4){0.f, 0.f, 0.f, 0.f};
    u32x4 At[4][2], B0[2][2], B1[2][2];
    const char* cA = S.a_ptr(cur); const char* cB = S.b_ptr(cur);
    if constexpr (GA) S.a_offs(cur, stR, stC, voffA);
    static_assert(SP2, "only the SP2 loop is kept");
    PG8_STAGE_B(PG8_SB(0, 0), cB); PG8_STAGE_B(PG8_SB(0, 1), cB + hstepB); PG8_STAGE_A(PG8_SA(0, 0), 0, cA, voffA); PG8_STAGE_A(PG8_SA(0, 1), 1, cA, voffA);
    if (wr == 1) PG8_BAR;
    PG8_WAIT_V(2); PG8_BAR;
    PG8_STAGE_B(PG8_SB(1, 0), cB + kstep); PG8_STAGE_A(PG8_SA(1, 0), 0, cA + kstep, voffA); PG8_STAGE_B(PG8_SB(1, 1), cB + hstepB + kstep);
    if constexpr (Epi::NST > 0) { PG8_WAIT_V(0); } else { PG8_WAIT_V(6); }
    PG8_BAR;
    for (;;) {
        const bool has_next = S.next(ui + 1, nxt);
        const char* nA = has_next ? S.a_ptr(nxt) : cA; const char* nB = has_next ? S.b_ptr(nxt) : cB;
        if constexpr (GA) { if (has_next) S.a_offs(nxt, stR, stC, nvoffA); else {
#pragma unroll
            for (int h = 0; h < 2; ++h)
#pragma unroll
                for (int i = 0; i < 2; ++i) nvoffA[h][i] = voffA[h][i]; } }
#define PG8_TRIP(t, WA) do { \
            const bool last = ((t) == nt - 2); \
            const char* a1 = cA + (size_t)((t) + 1) * kstep; \
            const char* a2 = last ? nA : cA + (size_t)((t) + 2) * kstep; const char* b2 = last ? nB : cB + (size_t)((t) + 2) * kstep; \
            const char* a3 = a2 + kstep; const char* b3 = b2 + kstep; \
            unsigned v2[2][2]; \
            _Pragma("unroll") for (int h = 0; h < 2; ++h) _Pragma("unroll") for (int i = 0; i < 2; ++i) v2[h][i] = (GA && last) ? nvoffA[h][i] : voffA[h][i]; \
            PG8_LDB(B0, 0, 0); PG8_LDB(B1, 0, 1); PG8_SCHED; PG8_LDA(At, 0, 0); PG8_STAGE_A(PG8_SA(1, 1), 1, a1, voffA); \
            WA; PG8_WAIT_L(0); PG8_BAR; PG8_SCHED8; PG8_MMA(0, 0, At, B0); PG8_MMA(0, 1, At, B1); PG8_SCHED8; PG8_BAR; PG8_SCHED; \
            PG8_LDA(At, 0, 1); PG8_STAGE_B(PG8_SB(0, 0), b2); PG8_STAGE_B(PG8_SB(0, 1), b2 + hstepB); PG8_STAGE_A(PG8_SA(0, 0), 0, a2, v2); \
            WA; PG8_WAIT_L(0); PG8_BAR; PG8_SCHED8; PG8_MMA(1, 0, At, B0); PG8_MMA(1, 1, At, B1); PG8_SCHED8; PG8_BAR; PG8_SCHED; \
            PG8_LDB(B0, 1, 0); PG8_LDB(B1, 1, 1); PG8_SCHED; PG8_LDA(At, 1, 0); PG8_STAGE_A(PG8_SA(0, 1), 1, a2, v2); \
            PG8_WAIT_V(8); PG8_WAIT_L(0); PG8_BAR; PG8_SCHED8; PG8_MMA(0, 0, At, B0); PG8_MMA(0, 1, At, B1); PG8_SCHED8; PG8_BAR; PG8_SCHED; \
            PG8_LDA(At, 1, 1); PG8_STAGE_B(PG8_SB(1, 0), b3); PG8_STAGE_B(PG8_SB(1, 1), b3 + hstepB); PG8_STAGE_A(PG8_SA(1, 0), 0, a3, v2); \
            PG8_WAIT_V(8); PG8_WAIT_L(0); PG8_BAR; PG8_SCHED8; PG8_MMA(1, 0, At, B0); PG8_MMA(1, 1, At, B1); PG8_SCHED8; PG8_BAR; PG8_SCHED; } while (0)
        static_assert((KDIM * ES) / (BK * 2) >= 4, "at least two trips per unit");
        if constexpr (Epi::NST > 0) { PG8_TRIP(0, PG8_WAIT_V8E); asm volatile("" : "+v"(voffB[0]), "+v"(voffB[1]), "+v"(voffA[0][0]), "+v"(voffA[0][1])); for (int t = 2; t < nt; t += 2) PG8_TRIP(t, PG8_WAIT_V(8)); }
        else { for (int t = 0; t < nt; t += 2) PG8_TRIP(t, PG8_WAIT_V(8)); }
#undef PG8_TRIP
        if constexpr (ALIGN_EPI) { if (wr == 0) PG8_BAR; }
        if constexpr (F8) asm volatile("s_nop 15\n\ts_nop 15\n\ts_nop 7" ::: "memory");
        E(acc, cur, wr, wc, fr, fq);
        if (!has_next) break;
        if (!E.keep(cur)) {
#pragma unroll
        for (int a = 0; a < 2; ++a)
#pragma unroll
            for (int b = 0; b < 2; ++b)
#pragma unroll
                for (int m = 0; m < 4; ++m)
#pragma unroll
                    for (int n = 0; n < 2; ++n) acc[a][b][m][n] = (f32x4){0.f, 0.f, 0.f, 0.f}; }
        cur = nxt; cA = nA; cB = nB; ++ui;
        if constexpr (GA) {
#pragma unroll
            for (int h = 0; h < 2; ++h)
#pragma unroll
                for (int i = 0; i < 2; ++i) voffA[h][i] = nvoffA[h][i]; }
        if constexpr (ALIGN_EPI) { if (wr == 1) PG8_BAR; }
    }
    PG8_WAIT_V(0);
    if constexpr (!ALIGN_EPI) { if (wr == 0) PG8_BAR; }
    PG8_BAR;
#undef PG8_SA
#undef PG8_SB
#undef PG8_STAGE_A
#undef PG8_STAGE_B
#undef PG8_LDA
#undef PG8_LDB
#undef PG8_MMA
#undef PG8_WAIT_V
#undef PG8_WAIT_V8E
#undef PG8_WAIT_L
#undef PG8_BAR
#undef PG8_SCHED
#undef PG8_SCHED8
}

struct SchedPlain {
    static constexpr bool GATHER = false;
    TileMap tm; const char* A; const char* Bt; size_t astep, bstep;
    __device__ __forceinline__ void init(const void* A_, int lda, const void* Bt_, int ldb, int M, int N, int G, int c, int es = 2) { tm.init(M / BM, N / BM, G, c); A = (const char*)A_; Bt = (const char*)Bt_; astep = (size_t)BM * lda * es; bstep = (size_t)BM * ldb * es; }
    __device__ __forceinline__ bool next(int i, Unit& u) const { u.e = 0; u.lt = 0; return tm.map(i, u.pm, u.pn); }
    __device__ __forceinline__ const char* a_ptr(const Unit& u) const { return A + (size_t)u.pm * astep; }
    __device__ __forceinline__ const char* b_ptr(const Unit& u) const { return Bt + (size_t)u.pn * bstep; }
};
struct SchedIn {
    static constexpr bool GATHER = false;
    TileMap tm; const char* A; const char* Bt;
    __device__ __forceinline__ bool next(int i, Unit& u) const { u.e = 0; u.lt = 0; return tm.map(i, u.pm, u.pn); }
    __device__ __forceinline__ const char* a_ptr(const Unit& u) const { return A + (size_t)u.pm * 256 * 1024; }
    __device__ __forceinline__ const char* b_ptr(const Unit& u) const { return Bt + (size_t)u.pn * 256 * 1024; }
};
struct SchedFour {
    static constexpr bool GATHER = false;
    const char* A; const char* Bt; int G, c;
    __device__ __forceinline__ bool next(int i, Unit& u) const { const int L = i * G + c; if (L >= 256) return false; u.pm = L >> 1; u.pn = L & 1; u.e = (L >> 4) & 1; u.lt = 0; return true; }
    __device__ __forceinline__ const char* a_ptr(const Unit& u) const { return A + (size_t)u.pm * 256 * 1024 * 2; }
    __device__ __forceinline__ const char* b_ptr(const Unit& u) const { return Bt + (size_t)(u.e * 512 + u.pn * 256) * 1024 * 2; }
};
struct SchedDFT {
    static constexpr bool GATHER = false;
    const char* DS; const char* Yt; int G, c;
    __device__ __forceinline__ bool next(int i, Unit& u) const {
        const int L = i * G + c; if (L >= 256) return false;
        const int Lx = ((L & 7) << 5) | (L >> 3);
        u.pm = Lx >> 5; u.lt = (Lx >> 4) & 1; u.e = (Lx >> 1) & 7; u.pn = Lx & 1; return true;
    }
    __device__ __forceinline__ const char* a_ptr(const Unit& u) const { return DS + ((size_t)u.pm * 256 * 4096 + (size_t)u.lt * 2048); }
    __device__ __forceinline__ const char* b_ptr(const Unit& u) const { return Yt + (((size_t)u.e * 512 + (size_t)u.pn * 256) * 4096 + (size_t)u.lt * 2048); }
};
struct SchedBranch {
    static constexpr bool GATHER = false;
    TileMap tm; const char* ws; const char* W;
    __device__ __forceinline__ bool next(int i, Unit& u) const { u.e = i % 3; u.lt = 0; return tm.map(i / 3, u.pm, u.pn); }
    __device__ __forceinline__ const char* a_ptr(const Unit& u) const { const size_t off = WS_ATTN + (size_t)u.e * (WS_FOUR - WS_ATTN) + (u.e == 2 ? (WS_PD - WS_ATTN - 2 * (WS_FOUR - WS_ATTN)) : (size_t)0); return ws + off + (size_t)u.pm * 256 * 512 * 2; }
    __device__ __forceinline__ const char* b_ptr(const Unit& u) const { return W + ((size_t)u.e * 1024 + (size_t)u.pn * 256) * 512 * 2; }
};
struct MoeTiles {
    const LAS int* t;
    __device__ __forceinline__ void locate(int pm, int& e, int& lt) const { int ee = 0;
#pragma unroll
        for (int j = 1; j < 8; ++j) ee += (pm >= t[j]) ? 1 : 0;
        ee = __builtin_amdgcn_readfirstlane(ee); e = ee; lt = pm - __builtin_amdgcn_readfirstlane(t[ee]); }
    __device__ __forceinline__ int count(int e) const { return __builtin_amdgcn_readfirstlane(t[16 + e]); }
    __device__ __forceinline__ int total() const { return __builtin_amdgcn_readfirstlane(t[8]); }
};
__device__ __forceinline__ void moe_tiles_setup(LAS int* t, const unsigned* gcnt, int tid) {
    if (tid == 0) { int s = 0;
        for (int e = 0; e < 8; ++e) { const int c = (int)__hip_atomic_load(gcnt + e, __ATOMIC_RELAXED, __HIP_MEMORY_SCOPE_AGENT); t[16 + e] = c; t[e] = s; s += (c + 255) >> 8; } t[8] = s; }
    __syncthreads();
}
template <int ES> struct SchedMoeUp {
    static constexpr bool GATHER = true;
    TileMap tm; MoeTiles mt; const char* H; const char* W13; const u32x2* rinfo;
    __device__ __forceinline__ bool next(int i, Unit& u) const { if (!tm.map(i, u.pm, u.pn)) return false; mt.locate(u.pm, u.e, u.lt); return true; }
    __device__ __forceinline__ const char* a_ptr(const Unit&) const { return H; }
    __device__ __forceinline__ const char* b_ptr(const Unit& u) const { return W13 + ((size_t)u.e * 7168 + (size_t)u.pn * 256) * 1024 * ES; }
    __device__ __forceinline__ void a_offs(const Unit& u, const int (&R)[2], const int (&C)[2], unsigned (&vo)[2][2]) const {
        const int cnt = mt.count(u.e);
#pragma unroll
        for (int h = 0; h < 2; ++h)
#pragma unroll
            for (int i = 0; i < 2; ++i) { const int slot = u.lt * 256 + h * 128 + R[i]; unsigned tok = 0u;
                if (slot < cnt) tok = rinfo[(size_t)u.e * 32768 + slot].x & 0x7fffffffu;
                vo[h][i] = tok * (unsigned)(1024 * ES) + (unsigned)C[i] * 2u; }
    }
};
template <int ES> struct SchedMoeDown {
    static constexpr bool GATHER = false;
    TileMap tm; MoeTiles mt; const char* ACT; const char* W2; int lim;
    __device__ __forceinline__ bool next(int i, Unit& u) const { if ((long)i * tm.G + tm.c >= lim) return false; if (!tm.map(i, u.pm, u.pn)) return false; mt.locate(u.pm, u.e, u.lt); return true; }
    __device__ __forceinline__ const char* a_ptr(const Unit& u) const { return ACT + (size_t)u.pm * 256 * 3584 * ES; }
    __device__ __forceinline__ const char* b_ptr(const Unit& u) const { return W2 + ((size_t)u.e * 1024 + (size_t)u.pn * 256) * 3584 * ES; }
};
template <int ES, int KS> struct SchedMoeDownTail {
    static constexpr bool GATHER = false; static constexpr int KSL = 3584 / KS;
    TileMap tm; MoeTiles mt; const char* ACT; const char* W2; int lim, ntail;
    __device__ __forceinline__ bool next(int i, Unit& u) const {
        const int upx = (tm.G >> 3) / KS, xcd = tm.c & 7, idx = tm.c >> 3; if (idx >= upx * KS) return false;
        const int ti = (i * 8 + xcd) * upx + idx / KS, ks = idx % KS; if (ti >= ntail) return false;
        tm.map_L(lim + ti, u.pm, u.pn); mt.locate(u.pm, u.e, u.lt); u.lt |= (ks << 8) | (ti << 12); return true; }
    __device__ __forceinline__ const char* a_ptr(const Unit& u) const { return ACT + ((size_t)u.pm * 256 * 3584 + (size_t)(((u.lt >> 8) & 15) * KSL)) * ES; }
    __device__ __forceinline__ const char* b_ptr(const Unit& u) const { return W2 + (((size_t)u.e * 1024 + (size_t)u.pn * 256) * 3584 + (size_t)(((u.lt >> 8) & 15) * KSL)) * ES; }
};

struct EpiIn {
    static constexpr bool PERM = true; static constexpr int NST = 0;
    __device__ __forceinline__ bool keep(const Unit&) const { return false; }
    bf16_t *QKV, *UP, *GATES; const float* qg; const float* kg; LAS float* P;
    const float* SH; const float* SW;
    __device__ __forceinline__ void operator()(f32x4 (&acc)[2][2][4][2], const Unit& u, int wr, int wc, int fr_in, int fq_in) const {
        int fr = fr_in, fq = fq_in; asm volatile("" : "+v"(fr), "+v"(fq));
        { const float* swp = SW + u.pn * 256 + wc * 32 + 8 * fq; const float* shp = SH + u.pm * BM + wr * 64 + fr;
          const float vsc = (u.pn >= 12 && u.pn < 18) ? 8.0f : 1.0f;
          const float gsc = u.pn >= 20 ? -1.4426950408889634f : 1.0f;
#pragma unroll
          for (int bj = 0; bj < 2; ++bj) { const f32x4 sw0 = *(const f32x4*)(swp + bj * HALF) * gsc, sw1 = *(const f32x4*)(swp + bj * HALF + 4) * gsc;
#pragma unroll
              for (int ai = 0; ai < 2; ++ai)
#pragma unroll
                  for (int m = 0; m < 4; ++m) { const float sa = shp[ai * HALF + m * 16] * vsc;
                      const i32x4 q0 = __builtin_bit_cast(i32x4, acc[ai][bj][m][0]), q1 = __builtin_bit_cast(i32x4, acc[ai][bj][m][1]);
                      acc[ai][bj][m][0] = (f32x4){(float)q0[0], (float)q0[1], (float)q0[2], (float)q0[3]} * sw0 * sa;
                      acc[ai][bj][m][1] = (f32x4){(float)q1[0], (float)q1[1], (float)q1[2], (float)q1[3]} * sw1 * sa; }
              asm volatile("" ::: "memory"); } }
        bf16_t* base; int ldc, colt; bool sg = false;
        if (u.pn < 18) { base = QKV; ldc = 4608; colt = u.pn * 256; }
        else if (u.pn < 20) { base = UP; ldc = 512; colt = (u.pn - 18) * 256; }
        else { base = GATES; ldc = 3072; colt = (u.pn - 20) * 256; sg = true; }
        if (u.pn < 12) {
#pragma unroll
            for (int ai = 0; ai < 2; ++ai)
#pragma unroll
                for (int m = 0; m < 4; ++m)
#pragma unroll
                    for (int bj = 0; bj < 2; ++bj) { const f32x4 a = acc[ai][bj][m][0], b = acc[ai][bj][m][1];
                        float ss = (a[0] * a[0] + a[1] * a[1]) + (a[2] * a[2] + a[3] * a[3]) + (b[0] * b[0] + b[1] * b[1]) + (b[2] * b[2] + b[3] * b[3]);
                        ss += __shfl_xor(ss, 16); ss += __shfl_xor(ss, 32);
                        if (fq == 0) P[((ai * HALF + wr * 64 + m * 16 + fr) * 2 + bj) * 4 + wc] = ss; }
            asm volatile("s_waitcnt lgkmcnt(0)" ::: "memory"); __builtin_amdgcn_s_barrier(); asm volatile("" ::: "memory");
            const float* gn = (u.pn < 6 ? qg : kg) + wc * 32 + 8 * fq; const float qs = u.pn < 6 ? 0.08838834764831845f * 64.0f : 8.0f;
            const f32x4 g0 = *(const f32x4*)gn * qs, g1 = *(const f32x4*)(gn + 4) * qs;
#pragma unroll
            for (int ai = 0; ai < 2; ++ai)
#pragma unroll
                for (int m = 0; m < 4; ++m)
#pragma unroll
                    for (int bj = 0; bj < 2; ++bj) { const f32x4 p = *(const LAS f32x4*)(P + ((ai * HALF + wr * 64 + m * 16 + fr) * 2 + bj) * 4);
                        const float rstd = __builtin_amdgcn_rsqf(((p[0] + p[1]) + (p[2] + p[3])) * (1.0f / 128.0f) + RMS_EPS);
                        acc[ai][bj][m][0] *= g0 * rstd; acc[ai][bj][m][1] *= g1 * rstd; }
        }
        const int row0 = u.pm * BM + wr * 64 + fr, col0 = colt + wc * 32 + 8 * fq;
#pragma unroll
        for (int ai = 0; ai < 2; ++ai)
#pragma unroll
            for (int m = 0; m < 4; ++m) { bf16_t* rowp = base + (size_t)(row0 + ai * HALF + m * 16) * ldc + col0;
#pragma unroll
                for (int bj = 0; bj < 2; ++bj) { f32x4 v0 = acc[ai][bj][m][0], v1 = acc[ai][bj][m][1];
                    if (sg) {
                        float y[8];
#pragma unroll
                        for (int j = 0; j < 4; ++j) {
                            y[j] = __builtin_amdgcn_rcpf(__builtin_amdgcn_fmed3f(__builtin_fmaf(__builtin_amdgcn_exp2f(v0[j]), 1.0f / 255.0f, 1.0f / 255.0f), 0.0f, 1.0f)) + 8388608.0f;
                            y[4 + j] = __builtin_amdgcn_rcpf(__builtin_amdgcn_fmed3f(__builtin_fmaf(__builtin_amdgcn_exp2f(v1[j]), 1.0f / 255.0f, 1.0f / 255.0f), 0.0f, 1.0f)) + 8388608.0f; }
                        u32x2 w;
                        w.x = __builtin_amdgcn_perm(__float_as_uint(y[1]), __float_as_uint(y[0]), 0x0c0c0400u) | __builtin_amdgcn_perm(__float_as_uint(y[3]), __float_as_uint(y[2]), 0x04000c0cu);
                        w.y = __builtin_amdgcn_perm(__float_as_uint(y[5]), __float_as_uint(y[4]), 0x0c0c0400u) | __builtin_amdgcn_perm(__float_as_uint(y[7]), __float_as_uint(y[6]), 0x04000c0cu);
                        *(u32x2*)((unsigned char*)base + ((size_t)(u.pm * 12 + (u.pn - 20)) << 16) + (size_t)((((((wr * 4 + wc) * 2 + ai) * 4 + m) * 2 + bj) << 9) + ((fq * 16 + fr) << 3))) = w;
                    } else if (u.pn < 12) { u32x2 w; w.x = pk8x4_nc(v0[0], v0[1], v0[2], v0[3]); w.y = pk8x4_nc(v1[0], v1[1], v1[2], v1[3]);
                        *(u32x2*)((unsigned char*)base + (size_t)(row0 + ai * HALF + m * 16) * ldc + col0 + bj * HALF) = w;
                    } else if (u.pn < 18) { u32x2 w; w.x = pk8x4(v0[0], v0[1], v0[2], v0[3]); w.y = pk8x4(v1[0], v1[1], v1[2], v1[3]);
                        *(u32x2*)((unsigned char*)base + (size_t)(row0 + ai * HALF + m * 16) * ldc + col0 + bj * HALF) = w;
                    } else {
                    u32x4 w; w.x = pk2(v0[0], v0[1]); w.y = pk2(v0[2], v0[3]); w.z = pk2(v1[0], v1[1]); w.w = pk2(v1[2], v1[3]);
                    *(u32x4*)(rowp + bj * HALF) = w; } } }
    }
};
struct EpiYtf {
    static constexpr bool PERM = false; static constexpr int NST = 0;
    __device__ __forceinline__ bool keep(const Unit&) const { return false; }
    unsigned char* Ytf;
    __device__ __forceinline__ void operator()(f32x4 (&acc)[2][2][4][2], const Unit& u, int wr, int wc, int fr, int fq) const {
        const int rowt = u.pm * BM, b = rowt >> 12, kbase = rowt & 4095;
        const int c0 = u.pn * 256 + wc * 32 + fr;
#pragma unroll
        for (int bj = 0; bj < 2; ++bj)
#pragma unroll
            for (int n = 0; n < 2; ++n) { unsigned char* cp = Ytf + ((size_t)b * 512 + c0 + bj * HALF + n * 16) * 4096 + kbase + wr * 64 + 4 * fq;
#pragma unroll
                for (int ai = 0; ai < 2; ++ai)
#pragma unroll
                    for (int m = 0; m < 4; ++m) { const f32x4 v = acc[ai][bj][m][n] * DFT_SY; *(unsigned*)(cp + ai * HALF + m * 16) = pk8x4(v[0], v[1], v[2], v[3]); } }
    }
};
struct EpiDFT {
    static constexpr bool PERM = true; static constexpr int NST = 16;
    __device__ __forceinline__ bool keep(const Unit&) const { return false; }
    bf16_t* P;
    __device__ __forceinline__ void operator()(f32x4 (&acc)[2][2][4][2], const Unit& u, int wr, int wc, int fr, int fq) const {
        const int row0 = (u.lt * 8 + u.e) * 2048 + u.pm * BM + wr * 64 + fr, col0 = u.pn * 256 + wc * 32 + 8 * fq;
#pragma unroll
        for (int ai = 0; ai < 2; ++ai)
#pragma unroll
            for (int m = 0; m < 4; ++m) { bf16_t* rowp = P + (size_t)(row0 + ai * HALF + m * 16) * 512 + col0;
#pragma unroll
                for (int bj = 0; bj < 2; ++bj) stx8(rowp + bj * HALF, 0, acc[ai][bj][m][0] * (1.0f / (DFT_SA * DFT_SY)), acc[ai][bj][m][1] * (1.0f / (DFT_SA * DFT_SY))); }
    }
};
__device__ __forceinline__ f32x4 ub4(unsigned w) { return (f32x4){(float)(w & 0xffu), (float)((w >> 8) & 0xffu), (float)((w >> 16) & 0xffu), (float)(w >> 24)}; }
struct EpiBranch {
    static constexpr bool PERM = true; static constexpr int NST = 16;
    const unsigned char* GATES; bf16_t* MERGED;
    __device__ __forceinline__ bool keep(const Unit& u) const { return u.e < 2; }
    __device__ __forceinline__ void operator()(f32x4 (&acc)[2][2][4][2], const Unit& u, int wr, int wc, int fr, int fq) const {
        const int row0 = u.pm * BM + wr * 64 + fr, col0 = u.pn * BM + wc * 32 + 8 * fq;
#pragma unroll
        for (int ai = 0; ai < 2; ++ai)
#pragma unroll
            for (int m = 0; m < 4; ++m) { const size_t row = (size_t)(row0 + ai * HALF + m * 16);
                const unsigned char* gp = GATES + ((size_t)(u.pm * 12 + u.e * 4 + u.pn) << 16) + (size_t)(((((wr * 4 + wc) * 2 + ai) * 4 + m) << 10) + ((fq * 16 + fr) << 3));
                if (u.e < 2) {
#pragma unroll
                    for (int bj = 0; bj < 2; ++bj) { const u32x2 ga = *(const u32x2*)(gp + bj * 512), gb = *(const u32x2*)(gp + 4 * 65536 + bj * 512);
                        const f32x4 a0 = ub4(ga.x), a1 = ub4(ga.y), b0 = ub4(gb.x), b1 = ub4(gb.y);
                        f32x4 r0, r1;
#pragma unroll
                        for (int j = 0; j < 4; ++j) { r0[j] = a0[j] * __builtin_amdgcn_rcpf(b0[j]); r1[j] = a1[j] * __builtin_amdgcn_rcpf(b1[j]); }
                        acc[ai][bj][m][0] *= r0; acc[ai][bj][m][1] *= r1; }
                } else { bf16_t* mp = MERGED + row * 1024 + col0;
#pragma unroll
                    for (int bj = 0; bj < 2; ++bj) { const u32x2 ga = *(const u32x2*)(gp + bj * 512);
                        const f32x4 v0 = acc[ai][bj][m][0] * ub4(ga.x) * (1.0f / 255.0f), v1 = acc[ai][bj][m][1] * ub4(ga.y) * (1.0f / 255.0f);
                        u32x4 w; w.x = pk2(v0[0], v0[1]); w.y = pk2(v0[2], v0[3]); w.z = pk2(v1[0], v1[1]); w.w = pk2(v1[2], v1[3]);
                        *(u32x4*)(mp + bj * HALF) = w; } }
                asm volatile("" ::: "memory"); }
    }
};
template <bool BASE_BF> struct EpiRes {
    static constexpr bool PERM = true; static constexpr int NST = 32;
    __device__ __forceinline__ bool keep(const Unit&) const { return false; }
    const void* base; bf16_t* out; float sc;
    __device__ __forceinline__ void operator()(f32x4 (&acc)[2][2][4][2], const Unit& u, int wr, int wc, int fr, int fq) const {
        const int row0 = u.pm * BM + wr * 64 + fr, col0 = u.pn * BM + wc * 32 + 8 * fq;
#pragma unroll
        for (int ai = 0; ai < 2; ++ai)
#pragma unroll
            for (int m = 0; m < 4; ++m) { const size_t off = (size_t)(row0 + ai * HALF + m * 16) * 1024 + col0;
#pragma unroll
                for (int bj = 0; bj < 2; ++bj) { const size_t i8 = (off + bj * HALF) >> 3; f32x4 b0, b1; ldx8<BASE_BF>(base, i8, b0, b1); stx8(out, i8, b0 + acc[ai][bj][m][0] * sc, b1 + acc[ai][bj][m][1] * sc); } }
    }
};
template <bool F8, bool IN8 = false> struct EpiSwiglu {
    static constexpr bool PERM = true; static constexpr int NST = IN8 ? 0 : 8;
    __device__ __forceinline__ bool keep(const Unit&) const { return false; }
    void* ACT; int ldc; float sin, sout; const float* SH; const float* SW;
    __device__ __forceinline__ void operator()(f32x4 (&acc)[2][2][4][2], const Unit& u, int wr, int wc, int fr_in, int fq_in) const {
        int fr = fr_in, fq = fq_in; asm volatile("" : "+v"(fr), "+v"(fq));
        const int row0 = u.pm * BM + wr * 64 + fr, col0 = u.pn * 128 + wc * 32 + 8 * fq;
        f32x4 sw[2][2];
        if constexpr (IN8) { const float* swp = SW + u.pn * 256 + wc * 32 + 8 * fq;
#pragma unroll
            for (int bj = 0; bj < 2; ++bj) { sw[bj][0] = *(const f32x4*)(swp + bj * HALF); sw[bj][1] = *(const f32x4*)(swp + bj * HALF + 4); }
            sw[1][0] *= sw[0][0]; sw[1][1] *= sw[0][1]; sw[0][0] *= -1.4426950408889634f; sw[0][1] *= -1.4426950408889634f; }
#pragma unroll
        for (int ai = 0; ai < 2; ++ai)
#pragma unroll
            for (int m = 0; m < 4; ++m) { const size_t eo = (size_t)(row0 + ai * HALF + m * 16) * ldc + col0;
                float o[8]; float sa = 1.0f, sa2 = 1.0f; if constexpr (IN8) { sa = SH[row0 + ai * HALF + m * 16]; sa2 = sa * sa * sout; }
#pragma unroll
                for (int n = 0; n < 2; ++n)
#pragma unroll
                    for (int j = 0; j < 4; ++j) {
                        if constexpr (IN8) { const float f0 = (float)__builtin_bit_cast(i32x4, acc[ai][0][m][n])[j], f1 = (float)__builtin_bit_cast(i32x4, acc[ai][1][m][n])[j];
                            o[n * 4 + j] = (f0 * f1) * sw[1][n][j] * sa2 * __builtin_amdgcn_rcpf(1.0f + __builtin_amdgcn_exp2f(f0 * sw[0][n][j] * sa)); }
                        else { const float a0 = acc[ai][0][m][n][j], b0 = acc[ai][1][m][n][j];
                            o[n * 4 + j] = (a0 * b0) * (sin * sin * sout) * __builtin_amdgcn_rcpf(1.0f + __builtin_amdgcn_exp2f(a0 * (sin * -1.4426950408889634f))); } }
                if constexpr (F8) { u32x2 w; w.x = pk8x4(o[0], o[1], o[2], o[3]); w.y = pk8x4(o[4], o[5], o[6], o[7]); *(u32x2*)((unsigned char*)ACT + eo) = w; }
                else { u32x4 w; w.x = pk2(o[0], o[1]); w.y = pk2(o[2], o[3]); w.z = pk2(o[4], o[5]); w.w = pk2(o[6], o[7]); *(u32x4*)((bf16_t*)ACT + eo) = w; } }
    }
};
struct EpiMoeDown {
    static constexpr bool PERM = true; static constexpr int NST = 0;
    __device__ __forceinline__ bool keep(const Unit&) const { return false; }
    bf16_t* x; bf16_t* y1; const u32x2* rinfo; MoeTiles mt; float sc; unsigned rmask = 0xffu;
    __device__ __forceinline__ void operator()(f32x4 (&acc)[2][2][4][2], const Unit& u, int wr, int wc, int fr, int fq) const {
        const int cnt = mt.count(u.e);
        const int col0 = u.pn * BM + wc * 32 + 8 * fq;
#pragma unroll
        for (int ai = 0; ai < 2; ++ai)
#pragma unroll
            for (int m = 0; m < 4; ++m) { const int slot = u.lt * 256 + ai * HALF + wr * 64 + m * 16 + fr;
                if (((rmask >> (ai * 4 + m)) & 1u) && slot < cnt) { const u32x2 ri = rinfo[(size_t)u.e * 32768 + slot]; const unsigned tok = ri.x & 0x7fffffffu; const bool k1 = (ri.x >> 31) != 0u; const float gt = __uint_as_float(ri.y) * sc;
                    const size_t off = (size_t)tok * 1024 + col0;
#pragma unroll
                    for (int bj = 0; bj < 2; ++bj) { const f32x4 v0 = acc[ai][bj][m][0] * gt, v1 = acc[ai][bj][m][1] * gt; const size_t i8 = (off + bj * HALF) >> 3;
                            if (k1) stx8(y1, i8, v0, v1);
                            else { f32x4 b0, b1; ldx8<true>(x, i8, b0, b1); stx8(x, i8, b0 + v0, b1 + v1); } } } }
    }
};
template <int KS> struct EpiMoeDownTail {
    static constexpr bool PERM = true; static constexpr int NST = 0;
    __device__ __forceinline__ bool keep(const Unit&) const { return false; }
    EpiMoeDown inner; float* slab; unsigned* cnt; LAS int* flag;
    __device__ __forceinline__ void operator()(f32x4 (&acc)[2][2][4][2], const Unit& u, int wr, int wc, int fr, int fq) const {
        const int ks = (u.lt >> 8) & 15, ti = u.lt >> 12, wave = wr * 4 + wc, lane = fq * 16 + fr;
        const __amdgpu_buffer_rsrc_t rs = __builtin_amdgcn_make_buffer_rsrc((void*)slab, (short)0, (int)(MOE_TAIL_MAX * KS * 262144), 0x00020000);
        { const unsigned wo = ((unsigned)(ti * KS + ks) * 8u + (unsigned)wave) * 32768u + (unsigned)lane * 16u;
#pragma unroll
          for (int j = 0; j < 32; ++j) __builtin_amdgcn_raw_buffer_store_b128(__builtin_bit_cast(u32x4, acc[j >> 4][(j >> 3) & 1][(j >> 1) & 3][j & 1]), rs, wo + (unsigned)j * 1024u, 0, 16); }
        asm volatile("s_waitcnt vmcnt(0)" ::: "memory");
        __syncthreads();
        if (threadIdx.x == 0) {
            (void)__hip_atomic_fetch_add(cnt + ti, 1u, __ATOMIC_RELAXED, __HIP_MEMORY_SCOPE_AGENT);
            unsigned sp = 0u;
            while (__hip_atomic_load(cnt + ti, __ATOMIC_RELAXED, __HIP_MEMORY_SCOPE_AGENT) < (unsigned)KS) { __builtin_amdgcn_s_sleep(1); if (++sp > (1u << 22)) break; }
            __builtin_amdgcn_fence(__ATOMIC_ACQUIRE, "agent"); asm volatile("s_waitcnt vmcnt(0)" ::: "memory"); }
        __syncthreads();
        const unsigned ro = ((unsigned)(ti * KS) * 8u + (unsigned)wave) * 32768u + (unsigned)lane * 16u;
        Unit v = u; v.lt = u.lt & 255;
#pragma unroll
        for (int rg = 0; rg < 8; ++rg) { if (rg % KS != ks) continue;
            const int ai = rg >> 2, m = rg & 3; f32x4 sm[4];
#pragma unroll
            for (int q = 0; q < 4; ++q) { const unsigned jo = (unsigned)(ai * 16 + (q >> 1) * 8 + m * 2 + (q & 1)) * 1024u;
                sm[q] = __builtin_bit_cast(f32x4, __builtin_amdgcn_raw_buffer_load_b128(rs, ro + jo, 0, 16));
#pragma unroll
                for (int k2 = 1; k2 < KS; ++k2) sm[q] += __builtin_bit_cast(f32x4, __builtin_amdgcn_raw_buffer_load_b128(rs, ro + (unsigned)k2 * 262144u + jo, 0, 16)); }
            asm volatile("" : "+v"(sm[0]), "+v"(sm[1]), "+v"(sm[2]), "+v"(sm[3]) :: "memory");
            f32x4 a2[2][2][4][2]; a2[ai][0][m][0] = sm[0]; a2[ai][0][m][1] = sm[1]; a2[ai][1][m][0] = sm[2]; a2[ai][1][m][1] = sm[3];
            EpiMoeDown in2 = inner; in2.rmask = 1u << rg; in2(a2, v, wr, wc, fr, fq); }
    }
};
}

struct Args {
    const float* in[21];
    float* out; unsigned char* ws;
    int ph_lo, ph_hi;
};
typedef const __attribute__((address_space(4))) Args CArgs;
__device__ __forceinline__ Args load_args(CArgs* ap) { Args a;
#pragma unroll
    for (int i = 0; i < 21; ++i) a.in[i] = ap->in[i];
    a.out = ap->out; a.ws = ap->ws; a.ph_lo = ap->ph_lo; a.ph_hi = ap->ph_hi; return a; }
enum { I_X = 0, I_NMG, I_WIN, I_QG, I_KG, I_RELB, I_POOLW, I_POOLS, I_WBA, I_WBF, I_WBP, I_WOUT, I_NFG, I_W1, I_W3, I_W2, I_RW, I_RB, I_MW1, I_MW3, I_MW2 };

__device__ __forceinline__ void cvt_item(const float* src, int ldsrc, int k0, int c0, bf16_t* dst, int ldd, int r0, LAS float* scr, int lane) {
#pragma unroll 8
    for (int i = 0; i < 32; ++i) { const int kk = 2 * i + (lane >> 5); scr[kk * 33 + (lane & 31)] = src[(size_t)(k0 + kk) * ldsrc + c0 + (lane & 31)]; }
    LDS_WAIT(); asm volatile("" ::: "memory");
    const int c = lane & 7;
#pragma unroll
    for (int j = 0; j < 4; ++j) { const int n = (lane >> 3) + 8 * j; const LAS float* s = scr + (8 * c) * 33 + n;
        u32x4 o; o.x = pk2(s[0 * 33], s[1 * 33]); o.y = pk2(s[2 * 33], s[3 * 33]); o.z = pk2(s[4 * 33], s[5 * 33]); o.w = pk2(s[6 * 33], s[7 * 33]);
        *(u32x4*)(dst + (size_t)(r0 + n) * ldd + k0 + 8 * c) = o; }
    LDS_WAIT(); asm volatile("" ::: "memory");
}
__device__ __forceinline__ void cvt_plain(const float* src, int ldsrc, int K, bf16_t* dst, int row0, int nrows, int coff, LAS float* scr, int gw, int NGW, int lane) {
    const int nblk = nrows / 32, items = (K / 64) * nblk;
    for (int it = gw; it < items; it += NGW) { const int kb = it / nblk, nb = it % nblk; const int r0 = row0 + nb * 32; cvt_item(src, ldsrc, kb * 64, r0 + coff, dst, K, r0, scr, lane); }
}
__device__ __forceinline__ void cvt_w13(const float* w1, const float* w3, int ncol, int nmat, bf16_t* dst, LAS float* scr, int gw, int NGW, int lane) {
    const int nblk = (2 * ncol) / 32, per = 16 * nblk, items = per * nmat;
    for (int it = gw; it < items; it += NGW) { const int e = it / per, r = it % per, kb = r / nblk, nb = r % nblk; const int r0 = nb * 32; const int s = (r0 >> 7) & 1, c0 = (r0 >> 8) * 128 + (r0 & 127);
        cvt_item((s ? w3 : w1) + (size_t)e * 1024 * ncol, ncol, kb * 64, c0, dst + (size_t)e * 2 * ncol * 1024, 1024, r0, scr, lane); }
}

__device__ __forceinline__ void cvt_item8(const float* src, int ldsrc, int k0, int c0, unsigned char* dst, int ldd, int r0, float sc, LAS float* scr, int lane) {
#pragma unroll 8
    for (int i = 0; i < 32; ++i) { const int kk = 2 * i + (lane >> 5); scr[kk * 33 + (lane & 31)] = src[(size_t)(k0 + kk) * ldsrc + c0 + (lane & 31)]; }
    LDS_WAIT(); asm volatile("" ::: "memory");
    const int c = lane & 7;
#pragma unroll
    for (int j = 0; j < 4; ++j) { const int n = (lane >> 3) + 8 * j; const LAS float* s = scr + (8 * c) * 33 + n;
        u32x2 o; o.x = pk8x4(s[0 * 33] * sc, s[1 * 33] * sc, s[2 * 33] * sc, s[3 * 33] * sc); o.y = pk8x4(s[4 * 33] * sc, s[5 * 33] * sc, s[6 * 33] * sc, s[7 * 33] * sc);
        *(u32x2*)(dst + (size_t)(r0 + n) * ldd + k0 + 8 * c) = o; }
    LDS_WAIT(); asm volatile("" ::: "memory");
}
__device__ __forceinline__ void cvt_plain8(const float* src, int ldsrc, int K, unsigned char* dst, int nrows, float sc, LAS float* scr, int gw, int NGW, int lane) {
    const int nblk = nrows / 32, items = (K / 64) * nblk;
    for (int it = gw; it < items; it += NGW) { const int kb = it / nblk, nb = it % nblk; cvt_item8(src, ldsrc, kb * 64, nb * 32, dst, K, nb * 32, sc, scr, lane); }
}
__device__ __forceinline__ void cvt_w13_8(const float* w1, const float* w3, int ncol, int nmat, unsigned char* dst, float sc, LAS float* scr, int gw, int NGW, int lane) {
    const int nblk = (2 * ncol) / 32, per = 16 * nblk, items = per * nmat;
    for (int it = gw; it < items; it += NGW) { const int e = it / per, r = it % per, kb = r / nblk, nb = r % nblk; const int r0 = nb * 32; const int s = (r0 >> 7) & 1, c0 = (r0 >> 8) * 128 + (r0 & 127);
        cvt_item8((s ? w3 : w1) + (size_t)e * 1024 * ncol, ncol, kb * 64, c0, dst + (size_t)e * 2 * ncol * 1024, 1024, r0, sc, scr, lane); }
}

__device__ __forceinline__ void w8_strip(const float* src, int ld, signed char* W8r0, float* SWr0, LAS float* smax, int wave, int lane) {
    const int n = lane & 31, kh = lane >> 5;
    const float* p = src + (size_t)(128 * wave + kh) * ld + n;
    float v[64];
#pragma unroll
    for (int i = 0; i < 64; ++i) v[i] = p[(size_t)(2 * i) * ld];
    float mx = 0.f;
#pragma unroll
    for (int i = 0; i < 64; ++i) mx = fmaxf(mx, fabsf(v[i]));
    mx = fmaxf(mx, __shfl_xor(mx, 32));
    if (lane < 32) smax[wave * 32 + n] = mx;
    __syncthreads();
    mx = smax[n];
#pragma unroll
    for (int w = 1; w < 8; ++w) mx = fmaxf(mx, smax[w * 32 + n]);
    mx = fmaxf(mx, 1e-30f);
    __syncthreads();
    if (wave == 0 && lane < 32) SWr0[n] = mx * (1.0f / 127.0f);
    const float inv = 127.0f / mx;
#pragma unroll
    for (int u = 0; u < 4; ++u) { unsigned wd[2][4];
#pragma unroll
        for (int tt = 0; tt < 2; ++tt)
#pragma unroll
            for (int e = 0; e < 4; ++e) { const int i0 = 8 * (2 * u + tt) + 2 * e;
                const int a0 = (int)rintf(v[i0] * inv), a1 = (int)rintf(v[i0 + 1] * inv); const int b0 = __shfl_xor(a0, 32), b1 = __shfl_xor(a1, 32);
                const int ev0 = kh ? b0 : a0, od0 = kh ? a0 : b0, ev1 = kh ? b1 : a1, od1 = kh ? a1 : b1;
                wd[tt][e] = ((unsigned)ev0 & 0xffu) | (((unsigned)od0 & 0xffu) << 8) | (((unsigned)ev1 & 0xffu) << 16) | ((unsigned)od1 << 24); }
        u32x4 o; o.x = kh ? wd[1][0] : wd[0][0]; o.y = kh ? wd[1][1] : wd[0][1]; o.z = kh ? wd[1][2] : wd[0][2]; o.w = kh ? wd[1][3] : wd[0][3];
        *(u32x4*)(W8r0 + (size_t)n * 1024 + 128 * wave + 16 * (2 * u + kh)) = o; }
}
__device__ __forceinline__ void w8_strips(const Args& a, unsigned char* ws, LAS unsigned char* lds, int vcu, int G, int wave, int lane) {
    LAS float* smax = (LAS float*)(lds + 131072);
    for (int sidx = vcu; sidx < DEPTH * 256 + 2 * 176; sidx += G) {
        if (sidx < DEPTH * 256) { const int l = sidx >> 8, st = sidx & 255, r0 = st * 32, c0 = r0 < 4608 ? r0 : r0 + 512;
            w8_strip(a.in[I_WIN] + (size_t)l * 1024 * SRC_IN + c0, SRC_IN, (signed char*)(ws + WS_WIN + (size_t)l * WIN_SLOT) + (size_t)r0 * 1024, (float*)(ws + WS_WIN + (size_t)l * WIN_SLOT + WIN_SW) + r0, smax, wave, lane); }
        else { const int q = sidx - DEPTH * 256, j = q >= 176 ? 1 : 0, st = q - j * 176, r0 = st * 32, sel = (r0 >> 7) & 1, c0 = (r0 >> 8) * 128 + (r0 & 127);
            if ((DENSE_UP8_MASK >> j) & 1) w8_strip((sel ? a.in[I_W3] : a.in[I_W1]) + (size_t)j * 1024 * FF + c0, FF, (signed char*)(ws + WS_W13 + (size_t)j * W13_SLOT) + (size_t)r0 * 1024, (float*)(ws + WS_W13 + (size_t)j * W13_SLOT + W13_SW) + r0, smax, wave, lane); }
    }
}

__device__ __forceinline__ void prologue_phase(const Args& a, LAS unsigned char* lds, int vcu, int G, int tid, int wave, int lane) {
    unsigned char* ws = a.ws;
    LAS float* scr = (LAS float*)(lds + wave * 16384);
    const int gw = vcu * NWAVES + wave, NGW = G * NWAVES;
    w8_strips(a, ws, lds, vcu, G, wave, lane);
    for (int it = gw; it < 4096 + 2 * 4224; it += NGW) {
        if (it < 4096) { const int l = it >> 10, r = it & 1023;
            if (r < 512) { const int q = r & 255; const float* src = (r < 256 ? a.in[I_WBA] : a.in[I_WBF]) + (size_t)l * 512 * 1024; bf16_t* dst = (bf16_t*)(ws + WS_WB) + ((size_t)l * 3 + (r >> 8)) * 1024 * 512;
                cvt_item(src, 1024, (q >> 5) * 64, (q & 31) * 32, dst, 512, (q & 31) * 32, scr, lane); }
            else { const int q = r - 512; cvt_item(a.in[I_WOUT] + (size_t)l * 1024 * 1024, 1024, (q >> 5) * 64, (q & 31) * 32, (bf16_t*)(ws + WS_WO) + (size_t)l * 1024 * 1024, 1024, (q & 31) * 32, scr, lane); }
        } else { const int r = it - 4096, j = r >= 4224 ? 1 : 0, q = r - j * 4224; const bool f8j = ((DENSE_F8_MASK >> j) & 1) != 0;
            bf16_t* d13 = (bf16_t*)(ws + WS_W13) + (size_t)j * 2 * FF * 1024; bf16_t* d2 = (bf16_t*)(ws + WS_W2) + (size_t)j * 1024 * FF;
            if (q < 2816) { if ((DENSE_UP8_MASK >> j) & 1) continue;
                const int kb = q / 176, nb = q % 176, r0 = nb * 32, sel = (r0 >> 7) & 1, c0 = (r0 >> 8) * 128 + (r0 & 127);
                const float* src = (sel ? a.in[I_W3] : a.in[I_W1]) + (size_t)j * 1024 * FF;
                if (f8j) cvt_item8(src, FF, kb * 64, c0, (unsigned char*)d13, 1024, r0, F8_SW, scr, lane); else cvt_item(src, FF, kb * 64, c0, d13, 1024, r0, scr, lane); }
            else { const int q2 = q - 2816, kb = q2 >> 5, nb = q2 & 31; const float* src = a.in[I_W2] + (size_t)j * FF * 1024;
                if (f8j) cvt_item8(src, 1024, kb * 64, nb * 32, (unsigned char*)d2, FF, nb * 32, F8_SW, scr, lane); else cvt_item(src, 1024, kb * 64, nb * 32, d2, FF, nb * 32, scr, lane); } }
    }
    __syncthreads();
    {
        LAS float* tab = (LAS float*)lds;
        if (tid < 256) { const int j = tid & 127; const float ang = (float)j * (1.0f / 64.0f); tab[tid] = (tid < 128 ? cospif(ang) : sinpif(ang)) * 0.08838834764831845f; }
        __syncthreads();
        for (int pr_ = 0; pr_ < 1 + PROL_C; ++pr_)
        for (int it = gw; it < DEPTH * 4 * 64; it += NGW) {
            const int l = it >> 8, g = (it >> 6) & 3, kk0 = (it & 63) * 16;
            const float* p = a.in[I_WIN] + ((size_t)l * 1024 + kk0 + (lane & 15)) * SRC_IN + 4608 + g * 128 + (lane >> 4);
            float av[32];
#pragma unroll
            for (int s_ = 0; s_ < 32; ++s_) av[s_] = p[4 * s_];
            bf16_t* WINF = (bf16_t*)(ws + WS_WIN + (size_t)l * WIN_SLOT + WIN_F);
            for (int nt_ = 0; nt_ < 16; ++nt_) { const int cs = nt_ >> 3, k2 = (nt_ & 7) * 16 + (lane & 15);
                f32x4 acc = {0.f, 0.f, 0.f, 0.f}; int idx = (k2 * (lane >> 4)) & 127; const int step = (4 * k2) & 127;
#pragma unroll
                for (int s_ = 0; s_ < 32; ++s_) { const float bv = tab[cs * 128 + idx]; idx = (idx + step) & 127; acc = __builtin_amdgcn_mfma_f32_16x16x4f32(av[s_], bv, acc, 0, 0, 0); }
                u32x2 w; w.x = pk2(acc[0], acc[1]); w.y = pk2(acc[2], acc[3]);
                *(u32x2*)(WINF + (size_t)(cs * 512 + g * 128 + k2) * 1024 + kk0 + 4 * (lane >> 4)) = w; }
        }
        __syncthreads();
    }
    for (int it = vcu; it < DEPTH * 4 * 16; it += G) {
        const int l = it >> 6, g = (it >> 4) & 3, db = it & 15;
        const int d = db * 64 + lane;
        float reg[128];
        const float* wbp = a.in[I_WBP] + ((size_t)l * 512 + g * 128) * 1024 + d;
        const float* ps = a.in[I_POOLS] + l * 512 + g * 128;
#pragma unroll
        for (int j = 0; j < 128; ++j) reg[j] = wbp[(size_t)j * 1024] * ps[j];
        const float* pw = a.in[I_POOLW] + ((size_t)(l * 4 + g) * 128) * 128;
        bf16_t* WB2 = (bf16_t*)(ws + WS_WB) + ((size_t)l * 3 + 2) * 1024 * 512;
        for (int o = 0; o < 16; ++o) { const int c = wave * 16 + o; const float* pr = pw + c * 128; float s = 0.f;
#pragma unroll
            for (int j = 0; j < 128; ++j) { s += pr[j] * reg[j]; if ((j & 15) == 15) __builtin_amdgcn_sched_barrier(0); }
            WB2[(size_t)d * 512 + g * 128 + c] = (bf16_t)(pk2(s, 0.f) & 0xffffu); }
    }
    {
        __syncthreads();
        LAS float* ctab = (LAS float*)lds;
        for (int j = tid; j < 4096; j += NTHR) ctab[j] = cospif((float)j * (1.0f / 2048.0f)) * 0.015625f;
        __syncthreads();
        unsigned char* DS = (unsigned char*)(ws + WS_DS);
        const int nthr = G * NTHR;
        for (int id = vcu * NTHR + tid; id < 2048 * 512; id += nthr) {
            const int k1 = id >> 9, col = (id & 511) * 8, cs = col >> 11, pos = col & 2047;
            float v[8];
#pragma unroll
            for (int j = 0; j < 8; ++j) v[j] = ctab[(k1 * (pos + j) + (cs ? 1024 : 0)) & 4095] * DFT_SA;
            u32x2 w; w.x = pk8x4(v[0], v[1], v[2], v[3]); w.y = pk8x4(v[4], v[5], v[6], v[7]);
            *(u32x2*)(DS + (size_t)k1 * 4096 + col) = w;
        }
    }
}

__device__ __forceinline__ unsigned q8x4(f32x4 y, float inv) { const int a = (int)rintf(y.x * inv), b = (int)rintf(y.y * inv), c = (int)rintf(y.z * inv), d = (int)rintf(y.w * inv);
    return ((unsigned)a & 0xffu) | (((unsigned)b & 0xffu) << 8) | (((unsigned)c & 0xffu) << 16) | ((unsigned)d << 24); }
__device__ __forceinline__ float wave_max(float v) {
#pragma unroll
    for (int o = 1; o < 64; o <<= 1) v = fmaxf(v, __shfl_xor(v, o));
    return v;
}
template <int QM>
__device__ __forceinline__ void norm_phase(const bf16_t* xsrc, const float* gain, void* h, float* sh, int vcu, int G, int wave, int lane) {
    constexpr bool F8 = QM == 1;
    const int gw = vcu * NWAVES + wave, NGW = G * NWAVES;
    f32x4 gv[4];
#pragma unroll
    for (int j = 0; j < 4; ++j) gv[j] = ((const f32x4*)gain)[lane + 64 * j];
    for (int m = gw; m < NTOK; m += NGW) {
        f32x4 v[4]; float s = 0.f;
#pragma unroll
        for (int j = 0; j < 4; ++j) v[j] = ldx4<true>(xsrc + (size_t)m * DM, lane + 64 * j);
#pragma unroll
        for (int j = 0; j < 4; ++j) s += (v[j].x * v[j].x + v[j].y * v[j].y) + (v[j].z * v[j].z + v[j].w * v[j].w);
        const float rstd = 1.0f / sqrtf(wave_sum(s) * (1.f / DM) + RMS_EPS);
        u32x2* o8 = (u32x2*)((bf16_t*)h + (size_t)m * DM) + lane; unsigned* o4 = (unsigned*)((unsigned char*)h + (size_t)m * DM) + lane;
        if constexpr (QM == 2) { float mx = 0.f;
#pragma unroll
            for (int j = 0; j < 4; ++j) { v[j] = v[j] * rstd * gv[j];
#pragma unroll
                for (int e = 0; e < 4; ++e) mx = fmaxf(mx, fabsf(v[j][e])); }
            mx = fmaxf(wave_max(mx), 1e-30f); const float inv = 127.0f / mx;
            if (lane == 0) sh[m] = mx * (1.0f / 127.0f);
#pragma unroll
            for (int j = 0; j < 4; ++j) o4[64 * j] = q8x4(v[j], inv);
        } else {
#pragma unroll
        for (int j = 0; j < 4; ++j) { const f32x4 y = v[j] * rstd * gv[j];
            if constexpr (F8) o4[64 * j] = pk8x4(y.x, y.y, y.z, y.w); else { u32x2 w; w.x = pk2(y.x, y.y); w.y = pk2(y.z, y.w); o8[64 * j] = w; } } }
    }
}
template <bool BF>
__device__ __forceinline__ void norm1_pair_phase(const void* xsrc_, const bf16_t* yadd, bf16_t* xdst, const float* gain, signed char* h8, float* sh, bf16_t* hf, int vcu, int G, int wave, int lane) {
    const char* xsrc = (const char*)xsrc_; constexpr size_t RB = (size_t)DM * (BF ? 2 : 4);
    const int gw = vcu * NWAVES + wave, NGW = G * NWAVES;
    f32x4 gv[4];
#pragma unroll
    for (int j = 0; j < 4; ++j) gv[j] = ((const f32x4*)gain)[lane + 64 * j];
    for (int idx = gw; idx < NBATCH * 2049; idx += NGW) {
        const int b = idx / 2049, j = idx - b * 2049; const bool pair = j >= 1 && j <= 2047;
        const int mA = b * SEQ + j, mB = b * SEQ + (pair ? SEQ - j : j);
        f32x4 va[4], vb[4];
#pragma unroll
        for (int q = 0; q < 4; ++q) { va[q] = ldx4<BF>(xsrc + (size_t)mA * RB, lane + 64 * q); vb[q] = ldx4<BF>(xsrc + (size_t)mB * RB, lane + 64 * q); }
        if (yadd) {
#pragma unroll
            for (int q = 0; q < 4; ++q) { va[q] += ldx4<true>(yadd + (size_t)mA * DM, lane + 64 * q); vb[q] += ldx4<true>(yadd + (size_t)mB * DM, lane + 64 * q); } }
        if (xdst) {
#pragma unroll
            for (int q = 0; q < 4; ++q) { stx4(xdst + (size_t)mA * DM, lane + 64 * q, va[q]); if (pair) stx4(xdst + (size_t)mB * DM, lane + 64 * q, vb[q]); } }
        float sa = 0.f, sb = 0.f;
#pragma unroll
        for (int q = 0; q < 4; ++q) { sa += (va[q].x * va[q].x + va[q].y * va[q].y) + (va[q].z * va[q].z + va[q].w * va[q].w); sb += (vb[q].x * vb[q].x + vb[q].y * vb[q].y) + (vb[q].z * vb[q].z + vb[q].w * vb[q].w); }
        const float ra = 1.0f / sqrtf(wave_sum(sa) * (1.f / DM) + RMS_EPS), rb = 1.0f / sqrtf(wave_sum(sb) * (1.f / DM) + RMS_EPS);
        float ma = 0.f, mb = 0.f;
#pragma unroll
        for (int q = 0; q < 4; ++q) { va[q] = va[q] * ra * gv[q]; vb[q] = vb[q] * rb * gv[q];
#pragma unroll
            for (int e = 0; e < 4; ++e) { ma = fmaxf(ma, fabsf(va[q][e])); mb = fmaxf(mb, fabsf(vb[q][e])); } }
        ma = fmaxf(wave_max(ma), 1e-30f); mb = fmaxf(wave_max(mb), 1e-30f);
        const float ia = 127.0f / ma, ib = 127.0f / mb;
        unsigned* oa = (unsigned*)(h8 + (size_t)mA * DM) + lane; unsigned* ob = (unsigned*)(h8 + (size_t)mB * DM) + lane;
        u32x2* os = (u32x2*)(hf + ((size_t)(b * 2 + 0) * 2048 + j) * DM) + lane; u32x2* od = (u32x2*)(hf + ((size_t)(b * 2 + 1) * 2048 + j) * DM) + lane;
        if (lane == 0) { sh[mA] = ma * (1.0f / 127.0f); if (pair) sh[mB] = mb * (1.0f / 127.0f); }
#pragma unroll
        for (int q = 0; q < 4; ++q) { const f32x4 ya = va[q], yb = vb[q];
            oa[64 * q] = q8x4(ya, ia);
            if (pair) { ob[64 * q] = q8x4(yb, ib);
                const f32x4 ys = ya + yb, yd = ya - yb; u32x2 w; w.x = pk2(ys.x, ys.y); w.y = pk2(ys.z, ys.w); os[64 * q] = w; w.x = pk2(yd.x, yd.y); w.y = pk2(yd.z, yd.w); od[64 * q] = w; }
            else if (j == 0) { u32x2 w; w.x = pk2(ya.x, ya.y); w.y = pk2(ya.z, ya.w); os[64 * q] = w; od[64 * q] = (u32x2){0u, 0u}; } }
    }
}
__device__ __forceinline__ void t2048_phase(const signed char* h8, const float* sh, const bf16_t* wcos, float* T, int vcu, int G, int wave, int lane) {
    const int gw = vcu * NWAVES + wave, NGW = G * NWAVES;
    for (int idx = gw; idx < NBATCH * 512; idx += NGW) { const int b = idx >> 9, c = idx & 511; const size_t row = (size_t)b * SEQ + 2048;
        const u32x4 a = ((const u32x4*)(h8 + row * DM))[lane];
        const u32x4* wp = (const u32x4*)(wcos + (size_t)c * DM) + 2 * lane; const u32x4 w0 = wp[0], w1 = wp[1];
        const unsigned aw[4] = {a.x, a.y, a.z, a.w}; const unsigned ww[8] = {w0.x, w0.y, w0.z, w0.w, w1.x, w1.y, w1.z, w1.w};
        float s = 0.f;
#pragma unroll
        for (int e = 0; e < 4; ++e) { const int q0 = (int)(aw[e] << 24) >> 24, q1 = (int)(aw[e] << 16) >> 24, q2 = (int)(aw[e] << 8) >> 24, q3 = (int)aw[e] >> 24;
            s += (float)q0 * bf_lo(ww[2 * e]) + (float)q1 * bf_hi(ww[2 * e]) + (float)q2 * bf_lo(ww[2 * e + 1]) + (float)q3 * bf_hi(ww[2 * e + 1]); }
        s = wave_sum(s) * sh[row];
        if (lane == 0) T[idx] = s; }
}
__device__ __forceinline__ void add_phase(float* out, const bf16_t* x, const bf16_t* y, int vcu, int G, int tid) {
    const int nthr = G * NTHR;
    for (int id = vcu * NTHR + tid; id < NTOK * DM / 8; id += nthr) { const u32x4 a = ((const u32x4*)x)[id], b = ((const u32x4*)y)[id];
        ((f32x4*)out)[2 * id] = (f32x4){bf_lo(a.x) + bf_lo(b.x), bf_hi(a.x) + bf_hi(b.x), bf_lo(a.y) + bf_lo(b.y), bf_hi(a.y) + bf_hi(b.y)};
        ((f32x4*)out)[2 * id + 1] = (f32x4){bf_lo(a.z) + bf_lo(b.z), bf_hi(a.z) + bf_hi(b.z), bf_lo(a.w) + bf_lo(b.w), bf_hi(a.w) + bf_hi(b.w)}; }
}
template <bool F8>
__device__ __forceinline__ void norm_router_phase(const bf16_t* x, const float* gain, const float* rw, const float* rb, void* h, unsigned* gcnt, u32x2* rinfo, unsigned long long* gran, const unsigned epoch,
                                                  LAS unsigned char* lds, int vcu, int G, int tid, int wave, int lane) {
    LAS unsigned* lcnt = (LAS unsigned*)(lds + MISC_OFF + 64);
    LAS unsigned* lbase = lcnt + 8;
    LAS unsigned* sel = lcnt + 16;
    LAS unsigned* wcnt = (LAS unsigned*)(lds + MISC_OFF + 3456);
    f32x4 gv[4];
#pragma unroll
    for (int j = 0; j < 4; ++j) gv[j] = ((const f32x4*)gain)[lane + 64 * j];
    float rwv[16][8];
#pragma unroll
    for (int j = 0; j < 4; ++j)
#pragma unroll
        for (int q = 0; q < 4; ++q) { const int d = 4 * lane + 256 * j + q; const f32x4 a0 = *(const f32x4*)(rw + d * 8), a1 = *(const f32x4*)(rw + d * 8 + 4);
            rwv[j * 4 + q][0] = a0[0]; rwv[j * 4 + q][1] = a0[1]; rwv[j * 4 + q][2] = a0[2]; rwv[j * 4 + q][3] = a0[3]; rwv[j * 4 + q][4] = a1[0]; rwv[j * 4 + q][5] = a1[1]; rwv[j * 4 + q][6] = a1[2]; rwv[j * 4 + q][7] = a1[3]; }
    float rbv[8];
#pragma unroll
    for (int e = 0; e < 8; ++e) rbv[e] = rb[e];
    for (int ck = vcu; ck < NTOK / 128; ck += G) {
        if (tid < 8) lcnt[tid] = 0u;
        __syncthreads();
        for (int rr = 0; rr < 16; ++rr) {
            const int rl = wave * 16 + rr, m = ck * 128 + rl;
            f32x4 v[4]; float s = 0.f;
#pragma unroll
            for (int j = 0; j < 4; ++j) { v[j] = ldx4<true>(x + (size_t)m * DM, lane + 64 * j); s += (v[j].x * v[j].x + v[j].y * v[j].y) + (v[j].z * v[j].z + v[j].w * v[j].w); }
            const float rstd = 1.0f / sqrtf(wave_sum(s) * (1.f / DM) + RMS_EPS);
            u32x2* o8 = (u32x2*)((bf16_t*)h + (size_t)m * DM) + lane; unsigned* o4 = (unsigned*)((unsigned char*)h + (size_t)m * DM) + lane;
            float lg[8];
#pragma unroll
            for (int e = 0; e < 8; ++e) lg[e] = 0.f;
#pragma unroll
            for (int j = 0; j < 4; ++j) { const f32x4 y = v[j] * rstd * gv[j];
                if constexpr (F8) o4[64 * j] = pk8x4(y.x, y.y, y.z, y.w); else { u32x2 w; w.x = pk2(y.x, y.y); w.y = pk2(y.z, y.w); o8[64 * j] = w; }
#pragma unroll
                for (int e = 0; e < 8; ++e) lg[e] += y.x * rwv[j * 4 + 0][e] + y.y * rwv[j * 4 + 1][e] + y.z * rwv[j * 4 + 2][e] + y.w * rwv[j * 4 + 3][e]; }
#pragma unroll
            for (int e = 0; e < 8; ++e) lg[e] = wave_sum(lg[e]) + rbv[e];
            int e0 = 0; float v0 = lg[0];
#pragma unroll
            for (int e = 1; e < 8; ++e) if (lg[e] > v0) { v0 = lg[e]; e0 = e; }
            int e1 = -1; float v1 = -3.0e38f;
#pragma unroll
            for (int e = 0; e < 8; ++e) if (e != e0 && lg[e] > v1) { v1 = lg[e]; e1 = e; }
            const float g0 = 1.0f / (1.0f + __expf(v1 - v0)), g1 = 1.0f - g0;
            if (lane == 0) {
                sel[(rl * 2 + 0) * 3 + 0] = (unsigned)e0; sel[(rl * 2 + 0) * 3 + 2] = __float_as_uint(g0);
                sel[(rl * 2 + 1) * 3 + 0] = (unsigned)e1; sel[(rl * 2 + 1) * 3 + 2] = __float_as_uint(g1);
            }
        }
        __syncthreads();
        unsigned my_e = 0u, my_rank = 0u;
        if (tid < 256) { my_e = sel[tid * 3 + 0];
#pragma unroll
            for (int ee = 0; ee < 8; ++ee) { const unsigned long long mk = __ballot(my_e == (unsigned)ee);
                if (my_e == (unsigned)ee) my_rank = (unsigned)__popcll(mk & ((1ull << lane) - 1ull));
                if (lane == ee) wcnt[wave * 8 + ee] = (unsigned)__popcll(mk); } }
        __syncthreads();
        if (tid < 8) { const unsigned c = wcnt[tid] + wcnt[8 + tid] + wcnt[16 + tid] + wcnt[24 + tid]; lcnt[tid] = c; lbase[tid] = 0u;
            __hip_atomic_store(gran + (size_t)ck * 8 + tid, ((unsigned long long)epoch << 32) | c, __ATOMIC_RELAXED, __HIP_MEMORY_SCOPE_AGENT); }
        __syncthreads();
        { unsigned part = 0u;
          for (int idx = tid; idx < ck * 8; idx += NTHR) { unsigned long long g = 0ull; unsigned sp = 0u;
              do { g = __hip_atomic_load(gran + idx, __ATOMIC_RELAXED, __HIP_MEMORY_SCOPE_AGENT); if ((unsigned)(g >> 32) == epoch) break; __builtin_amdgcn_s_sleep(1); } while (++sp < (1u << 20));
              part += (unsigned)g; }
          if (part) __hip_atomic_fetch_add(lbase + (tid & 7), part, __ATOMIC_RELAXED, __HIP_MEMORY_SCOPE_WORKGROUP); }
        __syncthreads();
        if (tid < 256) { const int rl = tid >> 1, k = tid & 1; const unsigned gb = sel[tid * 3 + 2]; unsigned rk = my_rank;
            for (int w2 = 0; w2 < wave; ++w2) rk += wcnt[w2 * 8 + my_e];
            u32x2 ri; ri.x = (unsigned)(ck * 128 + rl) | ((unsigned)k << 31); ri.y = gb; rinfo[(size_t)my_e * 32768 + lbase[my_e] + rk] = ri; }
        if (ck == NTOK / 128 - 1 && tid < 8) __hip_atomic_store(gcnt + tid, lbase[tid] + lcnt[tid], __ATOMIC_RELAXED, __HIP_MEMORY_SCOPE_AGENT);
        __syncthreads();
    }
}

__device__ __forceinline__ int kv_off(int row, int ch) { return 256 * row + 16 * (ch ^ (((row & 3) << 2) | ((row >> 2) & 3))); }
__device__ __forceinline__ int t5_bucket(int rel) {
    const int n = rel < 0 ? -rel : rel; const int ret = rel > 0 ? 16 : 0;
    const int v = n < 8 ? n : 8 + (n >= 15) + (n >= 27) + (n >= 50) + (n >= 91) + (n >= 166) + (n >= 305) + (n >= 559);
    return ret + v;
}
template <int OFF> __device__ __forceinline__ long tr8_read_off(unsigned addr) { long r; asm volatile("ds_read_b64_tr_b8 %0, %1 offset:%2" : "=v"(r) : "v"(addr), "i"(OFF) : "memory"); return r; }
__device__ __forceinline__ void attn_unit_rows(int u, int wave, int lane, unsigned (&koffs)[4]) {
    const int b = u / 384, rem = u % 384, h = rem >> 5, c = rem & 31, sh = 2 * (h >> 2), L = SEQ >> sh, cpr = 32 >> sh, r = c / cpr, jp = c % cpr;
#pragma unroll
    for (int i = 0; i < 4; ++i) { const int row = 8 * (wave * 4 + i) + (lane >> 3); const int ks = 128 * jp - 64 + row; const bool ok = ks >= 0 && ks < L;
        koffs[i] = (unsigned)(b * SEQ + ((ok ? ks : 0) << sh) + r) * 4608u + (unsigned)(1536 + h * 128); }
}
__device__ __forceinline__ void attn_phase(LAS unsigned char* lds, const bf16_t* qkv, const float* relb, bf16_t* og, float* lse,
                                           int vcu, int G, int tid, int wave, int lane) {
    LAS float* bt = (LAS float*)(lds + BT_OFF);
    for (int i = tid; i < 12 * 129; i += NTHR) { const int h = i / 129, o = i % 129 - 64; const int g = h >> 2; bt[h * 160 + o + 80] = relb[t5_bucket(o * (1 << (2 * g))) * 12 + h] * 1.4426950408889634f; }
    for (int i = tid; i < 128; i += NTHR) *(LAS u32x4*)(lds + AT_V + 256 * 128 + i * 16) = (u32x4){0u, 0u, 0u, 0u};
    const int qi = lane & 15, fq = lane >> 4;
    unsigned kbase[4], vbase[8];
    {
#pragma unroll
      for (int ks = 0; ks < 4; ++ks) kbase[ks] = (unsigned)(AT_K + 2048 * wave + 128 * qi + 16 * ((2 * ks + (fq >> 1)) ^ (qi & 7)) + 8 * (fq & 1));
      const int rp = (lane & 15) >> 1, cp = lane & 1, rowl = 16 * wave + 4 * fq + (rp & 3) + ((rp >> 2) ? 16 : 0), xv = 4 * (fq & 1) + (rp & 3);
#pragma unroll
      for (int dt = 0; dt < 8; ++dt) vbase[dt] = (unsigned)(AT_V + 128 * rowl + 16 * (dt ^ xv) + 8 * cp); }
    const char* qk8 = (const char*)qkv;
#define AT_ISSUE_V(koffs) do { const int ch_ = (lane & 7) ^ (lane >> 3); _Pragma("unroll") for (int i_ = 0; i_ < 4; ++i_) \
        __builtin_amdgcn_global_load_lds((const unsigned*)(qk8 + (koffs)[i_] + 1536 + ch_ * 16), (LAS unsigned*)(lds + AT_V + (wave * 4 + i_) * 1024), 16, 0, 0); } while (0)
#define AT_ISSUE_K(koffs) do { const int ch_ = (lane & 7) ^ (lane >> 3); _Pragma("unroll") for (int i_ = 0; i_ < 4; ++i_) \
        __builtin_amdgcn_global_load_lds((const unsigned*)(qk8 + (koffs)[i_] + ch_ * 16), (LAS unsigned*)(lds + AT_K + (wave * 4 + i_) * 1024), 16, 0, 0); } while (0)
#define AT_LOADQ(u_) do { const int b_ = (u_) / 384, rem_ = (u_) % 384, h_ = rem_ >> 5, c_ = rem_ & 31, sh_ = 2 * (h_ >> 2), cpr_ = 32 >> sh_, r_ = c_ / cpr_, jp_ = c_ % cpr_; \
        const char* p_q = qk8 + ((size_t)b_ * SEQ + (size_t)((128 * jp_ + 16 * wave + qi) << sh_) + r_) * 4608 + h_ * 128 + fq * 8; \
        _Pragma("unroll") for (int ks = 0; ks < 4; ++ks) Qf[ks] = *(const long*)(p_q + 32 * ks); } while (0)
    __syncthreads();
    unsigned koffs[4]; long Qf[4];
    int u = vcu;
    if (u < NBATCH * 12 * 32) { attn_unit_rows(u, wave, lane, koffs); AT_ISSUE_K(koffs); AT_LOADQ(u); AT_ISSUE_V(koffs); }
    for (; u < NBATCH * 12 * 32; u += G) {
        const int b = u / 384, rem = u % 384, h = rem >> 5, c = rem & 31, g = h >> 2, sh = 2 * g, L = SEQ >> sh, cpr = 32 >> sh;
        const int r = c / cpr, jp = c % cpr;
        const size_t tokq = (size_t)b * SEQ + (size_t)((128 * jp + 16 * wave + qi) << sh) + r;
        const bool has_next = (u + G) < NBATCH * 12 * 32;
        asm volatile("s_waitcnt vmcnt(4)" ::: "memory"); __builtin_amdgcn_s_barrier(); asm volatile("" ::: "memory");
        f32x4 S[10];
#pragma unroll
        for (int t = 0; t < 9; ++t) { f32x4 acc = {0.f, 0.f, 0.f, 0.f};
#pragma unroll
            for (int ks = 0; ks < 4; ++ks) { const long kf = *(const LAS long*)(lds + kbase[ks] + 2048 * t); acc = __builtin_amdgcn_mfma_f32_16x16x32_fp8_fp8(kf, Qf[ks], acc, 0, 0, 0); }
            S[t] = acc; }
        S[9] = (f32x4){0.f, 0.f, 0.f, 0.f};
        const LAS float* btl = bt + h * 160 + 16 + 4 * fq - qi;
        const int d0 = 4 * fq - qi - 64, kb0 = 128 * jp - 64 + 16 * wave + 4 * fq;
        const int lob = (-64 - d0) > (-kb0) ? (-64 - d0) : (-kb0), hib = (64 - d0) < (L - 1 - kb0) ? (64 - d0) : (L - 1 - kb0);
        float mx = -3.0e38f;
#pragma unroll
        for (int t = 0; t < 9; ++t)
#pragma unroll
            for (int j = 0; j < 4; ++j) { const int e = 16 * t + j; const bool ok = e >= lob && e <= hib;
                const float sv = ok ? S[t][j] * (1.4426950408889634f / 512.0f) + btl[e] : -1.0e30f; S[t][j] = sv; mx = fmaxf(mx, sv); }
        mx = fmaxf(mx, __shfl_xor(mx, 16)); mx = fmaxf(mx, __shfl_xor(mx, 32));
        float den = 0.f; const float mx8 = mx - 8.0f;
#pragma unroll
        for (int t = 0; t < 9; ++t)
#pragma unroll
            for (int j = 0; j < 4; ++j) { const float p = __builtin_amdgcn_exp2f(S[t][j] - mx8); S[t][j] = p; den += p; }
        den += __shfl_xor(den, 16); den += __shfl_xor(den, 32); den *= (1.0f / 256.0f);
        asm volatile("s_waitcnt vmcnt(0)" ::: "memory"); __builtin_amdgcn_s_barrier(); asm volatile("" ::: "memory");
        if (has_next) { attn_unit_rows(u + G, wave, lane, koffs); AT_ISSUE_K(koffs); AT_LOADQ(u + G); }
        f32x4 O[8];
#pragma unroll
        for (int dt = 0; dt < 8; ++dt) O[dt] = (f32x4){0.f, 0.f, 0.f, 0.f};
#define PV_STEP(T) { long pf; { u32x2 pw; pw.x = pk8x4_nc(S[2 * (T)][0], S[2 * (T)][1], S[2 * (T)][2], S[2 * (T)][3]); \
                pw.y = pk8x4_nc(S[2 * (T) + 1][0], S[2 * (T) + 1][1], S[2 * (T) + 1][2], S[2 * (T) + 1][3]); pf = __builtin_bit_cast(long, pw); } \
            long vf[8]; \
            _Pragma("unroll") for (int dt = 0; dt < 8; ++dt) vf[dt] = tr8_read_off<4096 * (T)>(vbase[dt]); \
            asm volatile("s_waitcnt lgkmcnt(0)" : "+v"(vf[0]), "+v"(vf[1]), "+v"(vf[2]), "+v"(vf[3]), "+v"(vf[4]), "+v"(vf[5]), "+v"(vf[6]), "+v"(vf[7]) :: "memory"); \
            _Pragma("unroll") for (int dt = 0; dt < 8; ++dt) O[dt] = __builtin_amdgcn_mfma_f32_16x16x32_fp8_fp8(vf[dt], pf, O[dt], 0, 0, 0); }
        PV_STEP(0) PV_STEP(1) PV_STEP(2) PV_STEP(3) PV_STEP(4)
#undef PV_STEP
        const float rden = 1.0f / den;
        unsigned char* op = (unsigned char*)og + ((size_t)g * NTOK + tokq) * 512 + (h & 3) * 128 + 4 * fq;
        const float rd16 = rden * (16.0f / 2048.0f);
#pragma unroll
        for (int dt = 0; dt < 8; ++dt) *(unsigned*)(op + 16 * dt) = pk8x4(O[dt][0] * rd16, O[dt][1] * rd16, O[dt][2] * rd16, O[dt][3] * rd16);
        if (fq == 0) lse[((size_t)g * NTOK + tokq) * 4 + (h & 3)] = (mx + __builtin_amdgcn_logf(den)) * 0.6931471805599453f;
        asm volatile("s_waitcnt lgkmcnt(0)" ::: "memory"); __builtin_amdgcn_s_barrier(); asm volatile("" ::: "memory");
        if (has_next) AT_ISSUE_V(koffs);
    }
    asm volatile("s_waitcnt vmcnt(0)" ::: "memory"); __syncthreads();
#undef AT_ISSUE_K
#undef AT_ISSUE_V
#undef AT_LOADQ
}

template <int HW>
__device__ __forceinline__ void pool_item(const bf16_t* UP, bf16_t* PD, int t, int ch) {
    const int pos = t & 4095;
    const bf16_t* base = UP + (size_t)(t - pos) * 512 + ch * 8;
    u32x4 v[2 * HW];
#pragma unroll
    for (int k = 0; k < 2 * HW; ++k) { const int p = pos - HW + k; const int pc = p < 0 ? 0 : (p > 4095 ? 4095 : p); v[k] = *(const u32x4*)(base + (size_t)pc * 512); }
    float s[8];
#pragma unroll
    for (int e = 0; e < 8; ++e) s[e] = 0.f;
    int cnt = 0;
#pragma unroll
    for (int k = 0; k < 2 * HW; ++k) { const int p = pos - HW + k; const bool ok = p >= 0 && p <= 4095; const float m = ok ? 1.0f : 0.0f; cnt += ok ? 1 : 0;
        s[0] += m * bf_lo(v[k].x); s[1] += m * bf_hi(v[k].x); s[2] += m * bf_lo(v[k].y); s[3] += m * bf_hi(v[k].y); s[4] += m * bf_lo(v[k].z); s[5] += m * bf_hi(v[k].z); s[6] += m * bf_lo(v[k].w); s[7] += m * bf_hi(v[k].w); }
    const u32x4 me = v[HW];
    const float rc = 1.0f / (float)cnt;
    u32x4 w; w.x = pk2(s[0] * rc - bf_lo(me.x), s[1] * rc - bf_hi(me.x)); w.y = pk2(s[2] * rc - bf_lo(me.y), s[3] * rc - bf_hi(me.y));
    w.z = pk2(s[4] * rc - bf_lo(me.z), s[5] * rc - bf_hi(me.z)); w.w = pk2(s[6] * rc - bf_lo(me.w), s[7] * rc - bf_hi(me.w));
    *(u32x4*)(PD + (size_t)t * 512 + ch * 8) = w;
}
__device__ __forceinline__ void pool_phase(const bf16_t* UP, bf16_t* PD, int vcu, int G, int wave, int lane) {
    const int gw = vcu * NWAVES + wave, NGW = G * NWAVES;
    for (int it = gw; it < (NTOK / 4) * 4; it += NGW) {
        const int g = it & 3, t = (it >> 2) * 4 + (lane >> 4), ch = g * 16 + (lane & 15);
        if (g == 0) pool_item<1>(UP, PD, t, ch); else if (g == 1) pool_item<2>(UP, PD, t, ch); else if (g == 2) pool_item<4>(UP, PD, t, ch); else pool_item<8>(UP, PD, t, ch);
    }
}
__device__ __forceinline__ void combine_phase(const bf16_t* og, const float* lse, bf16_t* ATTN, int vcu, int G, int tid) {
    const int nthr = G * NTHR;
    int z; asm volatile("v_mov_b32 %0, 0" : "=v"(z));
    for (int id = vcu * NTHR + tid + z; id < NTOK * 64; id += nthr) {
        const int t = id >> 6, ch = id & 63, hs = ch >> 4;
        const float l0 = lse[((size_t)0 * NTOK + t) * 4 + hs], l1 = lse[((size_t)1 * NTOK + t) * 4 + hs], l2 = lse[((size_t)2 * NTOK + t) * 4 + hs];
        const float m = fmaxf(l0, fmaxf(l1, l2)); float w0 = __expf(l0 - m), w1 = __expf(l1 - m), w2 = __expf(l2 - m); const float rs = 1.0f / (w0 + w1 + w2); w0 *= rs; w1 *= rs; w2 *= rs;
        const unsigned char* o8 = (const unsigned char*)og + (size_t)t * 512 + ch * 8;
        const u32x2 a = *(const u32x2*)o8, bq = *(const u32x2*)(o8 + (size_t)NTOK * 512), cq = *(const u32x2*)(o8 + (size_t)2 * NTOK * 512);
        w0 *= 0.0625f; w1 *= 0.0625f; w2 *= 0.0625f;
        const f32x2 a0 = __builtin_amdgcn_cvt_pk_f32_fp8((int)a.x, false), a1 = __builtin_amdgcn_cvt_pk_f32_fp8((int)a.x, true), a2 = __builtin_amdgcn_cvt_pk_f32_fp8((int)a.y, false), a3 = __builtin_amdgcn_cvt_pk_f32_fp8((int)a.y, true);
        const f32x2 b0 = __builtin_amdgcn_cvt_pk_f32_fp8((int)bq.x, false), b1 = __builtin_amdgcn_cvt_pk_f32_fp8((int)bq.x, true), b2 = __builtin_amdgcn_cvt_pk_f32_fp8((int)bq.y, false), b3 = __builtin_amdgcn_cvt_pk_f32_fp8((int)bq.y, true);
        const f32x2 c0 = __builtin_amdgcn_cvt_pk_f32_fp8((int)cq.x, false), c1 = __builtin_amdgcn_cvt_pk_f32_fp8((int)cq.x, true), c2 = __builtin_amdgcn_cvt_pk_f32_fp8((int)cq.y, false), c3 = __builtin_amdgcn_cvt_pk_f32_fp8((int)cq.y, true);
        const f32x2 r0 = a0 * w0 + b0 * w1 + c0 * w2, r1 = a1 * w0 + b1 * w1 + c1 * w2, r2 = a2 * w0 + b2 * w1 + c2 * w2, r3 = a3 * w0 + b3 * w1 + c3 * w2;
        u32x4 w; w.x = pk2(r0.x, r0.y); w.y = pk2(r1.x, r1.y); w.z = pk2(r2.x, r2.y); w.w = pk2(r3.x, r3.y);
        *(u32x4*)(ATTN + (size_t)t * 512 + ch * 8) = w;
    }
}

__device__ __forceinline__ void dft_combine_phase(const bf16_t* P, const float* T, const unsigned char* Ytf, bf16_t* FOUR, int vcu, int G, int tid, int wave, int lane) {
    const int nthr = G * NTHR;
    int z; asm volatile("v_mov_b32 %0, 0" : "=v"(z));
    for (int id = vcu * NTHR + tid + z; id < NBATCH * 2048 * 64; id += nthr) {
        const int ch = id & 63, k1 = (id >> 6) & 2047, b = id >> 17;
        const bf16_t* p1 = P + ((size_t)(b * 2048 + k1)) * 512 + ch * 8; const bf16_t* p2 = p1 + (size_t)8 * 2048 * 512;
        const u32x4 pa = *(const u32x4*)p1, pb = *(const u32x4*)p2;
        const f32x4 a0 = {bf_lo(pa.x), bf_hi(pa.x), bf_lo(pa.y), bf_hi(pa.y)}, a1 = {bf_lo(pa.z), bf_hi(pa.z), bf_lo(pa.w), bf_hi(pa.w)}, b0 = {bf_lo(pb.x), bf_hi(pb.x), bf_lo(pb.y), bf_hi(pb.y)}, b1 = {bf_lo(pb.z), bf_hi(pb.z), bf_lo(pb.w), bf_hi(pb.w)};
        const float sg = (k1 & 1) ? -0.015625f : 0.015625f;
        const f32x4 t0 = *(const f32x4*)(T + b * 512 + ch * 8) * sg, t1 = *(const f32x4*)(T + b * 512 + ch * 8 + 4) * sg;
        { const f32x4 v0 = a0 + b0 + t0, v1 = a1 + b1 + t1; u32x4 w; w.x = pk2(v0[0], v0[1]); w.y = pk2(v0[2], v0[3]); w.z = pk2(v1[0], v1[1]); w.w = pk2(v1[2], v1[3]);
          *(u32x4*)(FOUR + ((size_t)b * SEQ + k1) * 512 + ch * 8) = w; }
        if (k1 > 0) { const f32x4 v0 = a0 - b0 + t0, v1 = a1 - b1 + t1; u32x4 w; w.x = pk2(v0[0], v0[1]); w.y = pk2(v0[2], v0[3]); w.z = pk2(v1[0], v1[1]); w.w = pk2(v1[2], v1[3]);
          *(u32x4*)(FOUR + ((size_t)b * SEQ + SEQ - k1) * 512 + ch * 8) = w; }
    }
    const int gw = vcu * NWAVES + wave, NGW = G * NWAVES;
    for (int idx = gw; idx < NBATCH * 512; idx += NGW) {
        const u32x4* yp = (const u32x4*)(Ytf + (size_t)idx * 4096) + lane; float s = 0.f;
#pragma unroll
        for (int q = 0; q < 2; ++q) { const u32x4 y = yp[64 * q]; const unsigned yw[4] = {y.x, y.y, y.z, y.w};
#pragma unroll
            for (int e = 0; e < 4; ++e) { const f32x2 lo = __builtin_amdgcn_cvt_pk_f32_fp8((int)yw[e], false), hi = __builtin_amdgcn_cvt_pk_f32_fp8((int)yw[e], true); s += (lo[0] - lo[1]) + (hi[0] - hi[1]); } }
        s = wave_sum(s) * (1.0f / DFT_SY);
        if (lane == 0) { const float v = (s + T[idx]) * 0.015625f; FOUR[((size_t)(idx >> 9) * SEQ + 2048) * 512 + (idx & 511)] = (bf16_t)(pk2(v, 0.f) & 0xffffu); }
    }
}

constexpr int NSTEPS = 42;
#if ONE_LAUNCH
#define GRID_BAR() xcd_barrier(bar)
#else
#define GRID_BAR() do {} while (0)
#endif
#ifndef PHMASK
#define PHMASK 0xFFFFFFFFu
#endif
#ifndef SUBREP_A
#define SUBREP_A 0
#define SUBREP_B 0
#define SUBREP_C 0
#endif
#ifndef REPMASK
#define REPMASK 0u
#endif
#define REPS(k) (1 + (int)((REPMASK >> (k)) & 1u))
#define IN(k) (lo <= (k) && (k) < hi)
#ifndef BAR_REPS
#define BAR_REPS 1
#endif
#define SEAM(k) do { if (IN((k) + 1)) { for (int br_ = 0; br_ < BAR_REPS; ++br_) GRID_BAR(); } } while (0)
#define PHASE_BEGIN() const __attribute__((address_space(4))) Args* ap = (const __attribute__((address_space(4))) Args*)__builtin_amdgcn_kernarg_segment_ptr(); asm volatile("" : "+s"(ap)); const Args args = load_args(ap); \
    int G = G0, bx = bx0, vcu = vcu0; asm volatile("" : "+s"(G), "+s"(bx), "+s"(vcu)); (void)bx; \
    int tid = tid0; asm volatile("" : "+v"(tid)); const int lane = tid & 63; const int wave = __builtin_amdgcn_readfirstlane(tid >> 6); (void)lane; (void)wave; \
    unsigned char* ws = args.ws; unsigned* ctl = (unsigned*)(ws + WS_CTL); (void)ctl; bf16_t* const H = (bf16_t*)(ws + WS_H); (void)H; bf16_t* const X = (bf16_t*)(ws + WS_XB); (void)X; unsigned char* const OUTB = (unsigned char*)args.out; (void)OUTB; u32x2* const RINFO = (u32x2*)(ws + WS_RINFO); (void)RINFO;

template <int l>
__device__ __forceinline__ void run_layer(LAS unsigned char* lds, const int tid0, const int G0, const int bx0, const int vcu0, const int lo, const int hi, const XcdBarrier& bar) {
        constexpr int s0 = 1 + 10 * l; constexpr bool moe = (l & 1) != 0; constexpr int jj = l >> 1;
        if ((PHMASK & 2u) && IN(s0 + 0)) { for (int rep_ = 0; rep_ < REPS(1); ++rep_) { PHASE_BEGIN(); asm volatile("; ==PH 1");
            const float* gain = args.in[I_NMG] + l * DM;
            bf16_t* const HF = (bf16_t*)(ws + WS_HF); signed char* const H8 = (signed char*)(ws + WS_H); float* const SH = (float*)(ws + WS_H + H_SH);
            if constexpr (l == 0) norm1_pair_phase<false>(args.in[I_X], nullptr, nullptr, gain, H8, SH, HF, vcu, G, wave, lane);
            else if constexpr (l == 2) norm1_pair_phase<true>(X, (const bf16_t*)(ws + WS_Y1), X, gain, H8, SH, HF, vcu, G, wave, lane);
            else norm1_pair_phase<true>(X, nullptr, nullptr, gain, H8, SH, HF, vcu, G, wave, lane);
            }
            SEAM(s0 + 0);
        }
        if ((PHMASK & 4u) && IN(s0 + 1)) { for (int rep_ = 0; rep_ < REPS(2); ++rep_) { PHASE_BEGIN(); asm volatile("; ==PH 2");
            const char* WINl = (const char*)(ws + WS_WIN + (size_t)l * WIN_SLOT);
            { pg8::SchedIn S; S.tm.init(NTOK / 256, 32, G, bx); S.A = (const char*)H; S.Bt = WINl;
              pg8::EpiIn E{(bf16_t*)(ws + WS_QKV), (bf16_t*)(ws + WS_UP), (bf16_t*)(ws + WS_GATES), args.in[I_QG] + l * 128, args.in[I_KG] + l * 128, (LAS float*)(lds + 131072), (const float*)(ws + WS_H + H_SH), (const float*)(WINl + WIN_SW)};
              pg8::gemm_phase<pg8::EpiIn, pg8::SchedIn, 1024, 1024, 1024, false, 2>(lds, S, E, tid); }
            { pg8::SchedFour S; S.A = (const char*)(ws + WS_HF); S.Bt = WINl + WIN_F; S.G = G; S.c = bx;
              pg8::EpiYtf E{(unsigned char*)(ws + WS_YT)};
              pg8::gemm_phase<pg8::EpiYtf, pg8::SchedFour, 1024, 1024, 1024, true>(lds, S, E, tid); }
            }
            SEAM(s0 + 1);
        }
        if ((PHMASK & 8u) && IN(s0 + 2)) { for (int rep_ = 0; rep_ < REPS(3); ++rep_) { PHASE_BEGIN(); asm volatile("; ==PH 3");
            { pg8::SchedDFT S; S.DS = (const char*)(ws + WS_DS); S.Yt = (const char*)(ws + WS_YT); S.G = G; S.c = bx;
              pg8::EpiDFT E{(bf16_t*)(ws + WS_SLAB)};
              pg8::gemm_phase<pg8::EpiDFT, pg8::SchedDFT, 2048, 4096, 4096, false, 1>(lds, S, E, tid); }
            __syncthreads();
            { int tid2 = tid; asm volatile("" : "+v"(tid2)); const int lane2 = tid2 & 63, wave2 = __builtin_amdgcn_readfirstlane(tid2 >> 6);
              attn_phase(lds, (const bf16_t*)(ws + WS_QKV), args.in[I_RELB], (bf16_t*)(ws + WS_OG), (float*)(ws + WS_LSE), vcu, G, tid2, wave2, lane2);
              t2048_phase((const signed char*)(ws + WS_H), (const float*)(ws + WS_H + H_SH), (const bf16_t*)(ws + WS_WIN + (size_t)l * WIN_SLOT + WIN_F), (float*)(ws + WS_T2048), vcu, G, wave2, lane2);
              pool_phase((const bf16_t*)(ws + WS_UP), (bf16_t*)(ws + WS_PD), vcu, G, wave2, lane2); }
            }
            SEAM(s0 + 2);
        }
        if ((PHMASK & 16u) && IN(s0 + 3)) { PHASE_BEGIN(); asm volatile("; ==PH 4");
            combine_phase((const bf16_t*)(ws + WS_OG), (const float*)(ws + WS_LSE), (bf16_t*)(ws + WS_ATTN), vcu, G, tid);
            dft_combine_phase((const bf16_t*)(ws + WS_SLAB), (const float*)(ws + WS_T2048), (const unsigned char*)(ws + WS_YT), (bf16_t*)(ws + WS_FOUR), vcu, G, tid, wave, lane);
            SEAM(s0 + 3);
        }
        if ((PHMASK & 32u) && IN(s0 + 5)) { for (int rep_ = 0; rep_ < REPS(5); ++rep_) { PHASE_BEGIN(); asm volatile("; ==PH 5");
            pg8::SchedBranch S; S.tm.init(NTOK / 256, 4, G, bx); S.ws = (const char*)ws;
            S.W = (const char*)((const bf16_t*)(ws + WS_WB) + (size_t)l * 3 * 1024 * 512);
            pg8::EpiBranch E{(const unsigned char*)(ws + WS_GATES), (bf16_t*)(ws + WS_MERGED)};
            pg8::gemm_phase<pg8::EpiBranch, pg8::SchedBranch, 512, 512, 512>(lds, S, E, tid);
            }
            SEAM(s0 + 5);
        }
        if ((PHMASK & 64u) && IN(s0 + 6)) { for (int rep_ = 0; rep_ < REPS(6); ++rep_) { PHASE_BEGIN(); asm volatile("; ==PH 6");
            pg8::SchedPlain S; S.init((const bf16_t*)(ws + WS_MERGED), 1024, (const bf16_t*)(ws + WS_WO) + (size_t)l * 1024 * 1024, 1024, NTOK, 1024, G, bx);
            pg8::EpiRes<l != 0> E{l == 0 ? (const void*)args.in[I_X] : (const void*)X, X, 1.0f};
            pg8::gemm_phase<pg8::EpiRes<l != 0>, pg8::SchedPlain, 1024, 1024, 1024>(lds, S, E, tid);
            }
            SEAM(s0 + 6);
        }
        constexpr bool f8 = moe && ((MOE_F8_MASK >> jj) & 1) != 0; constexpr bool f8d = !moe && ((DENSE_F8_MASK >> jj) & 1) != 0; constexpr bool i8d = !moe && ((DENSE_UP8_MASK >> jj) & 1) != 0;
        if ((PHMASK & 128u) && IN(s0 + 7)) { for (int rep_ = 0; rep_ < REPS(7); ++rep_) { PHASE_BEGIN(); asm volatile("; ==PH 7");
            const float* gain = args.in[I_NFG] + l * DM;
            if constexpr (!moe) norm_phase<i8d ? 2 : (f8d ? 1 : 0)>(X, gain, H, (float*)(ws + WS_H + H_SH), vcu, G, wave, lane);
            else {
                norm_router_phase<f8>(X, gain, args.in[I_RW] + (size_t)jj * 1024 * 8, args.in[I_RB] + jj * 8, H, ctl + CW_GCNT + jj * 16, RINFO, (unsigned long long*)(ctl + CW_GRAN) + jj * 2048, (unsigned)jj + 1u, lds, vcu, G, tid, wave, lane);
                LAS float* scr = (LAS float*)(lds + wave * 16384);
                const int gw = vcu * NWAVES + wave, NGW = G * NWAVES;
                const float* mw1 = args.in[I_MW1] + (size_t)jj * 8 * 1024 * ED; const float* mw3 = args.in[I_MW3] + (size_t)jj * 8 * 1024 * ED;
                for (int sr_ = 0; sr_ < 1 + SUBREP_C; ++sr_)
                if constexpr (f8) {
                    cvt_w13_8(mw1, mw3, ED, 8, OUTB, F8_SW, scr, gw, NGW, lane);
                    for (int e = 0; e < 8; ++e) cvt_plain8(args.in[I_MW2] + ((size_t)jj * 8 + e) * ED * 1024, 1024, ED, (unsigned char*)(ws + WS_WM2) + (size_t)e * 1024 * ED, 1024, F8_SW, scr, gw, NGW, lane);
                } else {
                    cvt_w13(mw1, mw3, ED, 8, (bf16_t*)OUTB, scr, gw, NGW, lane);
                    for (int e = 0; e < 8; ++e) cvt_plain(args.in[I_MW2] + ((size_t)jj * 8 + e) * ED * 1024, 1024, ED, (bf16_t*)(ws + WS_WM2) + (size_t)e * 1024 * ED, 0, 1024, 0, scr, gw, NGW, lane);
                }
            }
            }
            SEAM(s0 + 7);
        }
        if ((PHMASK & 256u) && IN(s0 + 8)) { for (int rep_ = 0; rep_ < REPS(8); ++rep_) { PHASE_BEGIN(); asm volatile("; ==PH 8");
            if constexpr (!moe) {
                pg8::SchedPlain S; S.init(H, 1024, (const void*)(ws + WS_W13 + (size_t)jj * W13_SLOT), 1024, NTOK, 2 * FF, G, bx, (f8d || i8d) ? 1 : 2);
                pg8::EpiSwiglu<f8d, i8d> E{(void*)(ws + WS_ACT), FF, f8d ? 1.0f / F8_SW : 1.0f, f8d ? F8_SACT : 1.0f, (const float*)(ws + WS_H + H_SH), (const float*)(ws + WS_W13 + (size_t)jj * W13_SLOT + W13_SW)};
                pg8::gemm_phase<pg8::EpiSwiglu<f8d, i8d>, pg8::SchedPlain, 1024, 1024, 1024, false, i8d ? 2 : (f8d ? 1 : 0)>(lds, S, E, tid);
            } else {
                pg8::moe_tiles_setup((LAS int*)(lds + MISC_OFF + 3328), ctl + CW_GCNT + jj * 16, tid);
                pg8::SchedMoeUp<f8 ? 1 : 2> S; S.mt.t = (const LAS int*)(lds + MISC_OFF + 3328); S.tm.init(S.mt.total(), 28, G, bx); S.H = (const char*)H; S.W13 = (const char*)OUTB; S.rinfo = RINFO;
                pg8::EpiSwiglu<f8> E{(void*)(ws + WS_ACT), ED, f8 ? 1.0f / F8_SW : 1.0f, f8 ? F8_SACT : 1.0f, nullptr, nullptr};
                pg8::gemm_phase<pg8::EpiSwiglu<f8>, pg8::SchedMoeUp<f8 ? 1 : 2>, 1024, 1024, 1024, false, f8 ? 1 : 0>(lds, S, E, tid);
            }
            }
            SEAM(s0 + 8);
        }
        if ((PHMASK & 512u) && IN(s0 + 9)) { for (int rep_ = 0; rep_ < REPS(9); ++rep_) { PHASE_BEGIN(); asm volatile("; ==PH 9");
            if constexpr (!moe) {
                pg8::SchedPlain S; S.init((const bf16_t*)(ws + WS_ACT), FF, (const bf16_t*)(ws + WS_W2) + (size_t)jj * 1024 * FF, FF, NTOK, 1024, G, bx, f8d ? 1 : 2);
                pg8::EpiRes<true> E{X, X, f8d ? 1.0f / (F8_SW * F8_SACT) : 1.0f};
                pg8::gemm_phase<pg8::EpiRes<true>, pg8::SchedPlain, FF, FF, FF, false, f8d ? 1 : 0>(lds, S, E, tid);
            } else {
                pg8::moe_tiles_setup((LAS int*)(lds + MISC_OFF + 3328), ctl + CW_GCNT + jj * 16, tid);
                pg8::SchedMoeDown<f8 ? 1 : 2> S; S.mt.t = (const LAS int*)(lds + MISC_OFF + 3328); S.tm.init(S.mt.total(), 4, G, bx); S.ACT = (const char*)(ws + WS_ACT); S.W2 = (const char*)(ws + WS_WM2);
                const int nwg_ = S.mt.total() * 4; int lim_ = (nwg_ / G) * G, ntail_ = nwg_ - lim_; if (lim_ == 0 || ntail_ > MOE_TAIL_MAX) { lim_ = nwg_; ntail_ = 0; }
                S.lim = lim_;
                pg8::EpiMoeDown E{X, (bf16_t*)(ws + WS_Y1), RINFO, S.mt, f8 ? 1.0f / (F8_SW * F8_SACT) : 1.0f};
                pg8::gemm_phase<pg8::EpiMoeDown, pg8::SchedMoeDown<f8 ? 1 : 2>, ED, ED, ED, false, f8 ? 1 : 0>(lds, S, E, tid);
                if (ntail_ > 0) {
                    pg8::SchedMoeDownTail<f8 ? 1 : 2, MOE_KS> ST; ST.tm = S.tm; ST.mt = S.mt; ST.ACT = S.ACT; ST.W2 = S.W2; ST.lim = lim_; ST.ntail = ntail_;
                    pg8::EpiMoeDownTail<MOE_KS> ET{E, (float*)OUTB, ctl + CW_TAIL + jj * 64, (LAS int*)(lds + MISC_OFF + 3328) + 31};
                    pg8::gemm_phase<pg8::EpiMoeDownTail<MOE_KS>, pg8::SchedMoeDownTail<f8 ? 1 : 2, MOE_KS>, ED / MOE_KS, ED, ED, false, f8 ? 1 : 0>(lds, ST, ET, tid);
                }
            }
            }
            SEAM(s0 + 9);
        }
    }

__global__ void __launch_bounds__(NTHR, 2) fwd_kernel(Args args_by_value) {
    extern __shared__ __attribute__((aligned(16))) unsigned char lds_raw[];
    LAS unsigned char* lds = (LAS unsigned char*)lds_raw;
    const int tid0 = threadIdx.x;
    const int G0 = gridDim.x; const int bx0 = blockIdx.x; const int vcu0 = (G0 % 8 == 0) ? (bx0 % 8) * (G0 / 8) + bx0 / 8 : bx0;
    volatile LAS unsigned* MISC = (volatile LAS unsigned*)(lds + MISC_OFF);
    if (tid0 < 16) MISC[tid0] = 0u;
    __syncthreads();
#if ONE_LAUNCH
    XcdBarrier bar = xcd_barrier_post((unsigned*)(args_by_value.ws + WS_CTL) + CW_BAR, MISC);
#else
    XcdBarrier bar; bar.bar = nullptr; bar.x = 0; bar.st = MISC;
#endif
    const int lo = args_by_value.ph_lo, hi = args_by_value.ph_hi;
    if ((PHMASK & 1u) && IN(0)) { for (int rep_ = 0; rep_ < REPS(0); ++rep_) { PHASE_BEGIN(); asm volatile("; ==PH 0"); prologue_phase(args, lds, vcu, G, tid, wave, lane); __syncthreads(); }   }
    run_layer<0>(lds, tid0, G0, bx0, vcu0, lo, hi, bar);
    run_layer<1>(lds, tid0, G0, bx0, vcu0, lo, hi, bar);
    run_layer<2>(lds, tid0, G0, bx0, vcu0, lo, hi, bar);
    run_layer<3>(lds, tid0, G0, bx0, vcu0, lo, hi, bar);
    if ((PHMASK & 1024u) && IN(41)) { PHASE_BEGIN(); add_phase(args.out, X, (const bf16_t*)(ws + WS_Y1), vcu, G, tid); }
#undef IN
#undef SEAM
}

extern "C" void kernel_launch(void* const* d_in, const int* in_sizes, int n_in, void* d_out, int out_size, void* d_ws, size_t ws_size, hipStream_t stream) {
    static int grid = 0;
    if (grid == 0) {
        if (n_in != 21 || in_sizes[0] != NTOK * DM || out_size != NTOK * DM || ws_size < WS_END) {
            fprintf(stderr, "kernel_launch: unexpected problem (n_in %d, in0 %d, out %d, ws %zu < %zu?); nothing launched\n", n_in, n_in > 0 ? in_sizes[0] : -1, out_size, ws_size, (size_t)WS_END); grid = -1; return; }
        int dev = 0, cus = 0, per_cu = 0;
        if (hipGetDevice(&dev) != hipSuccess || hipDeviceGetAttribute(&cus, hipDeviceAttributeMultiprocessorCount, dev) != hipSuccess) { grid = -1; return; }
        if (hipFuncSetAttribute((const void*)fwd_kernel, hipFuncAttributeMaxDynamicSharedMemorySize, LDS_BYTES) != hipSuccess) { fprintf(stderr, "kernel_launch: hipFuncSetAttribute failed\n"); grid = -1; return; }
        if (hipOccupancyMaxActiveBlocksPerMultiprocessor(&per_cu, (const void*)fwd_kernel, NTHR, LDS_BYTES) != hipSuccess || per_cu < 1) { fprintf(stderr, "kernel_launch: occupancy query reports %d\n", per_cu); }
        (void)hipGetLastError();
        grid = cus;
    }
    if (grid < 0) return;
    (void)hipMemsetAsync((char*)d_ws + WS_CTL, 0, CTL_ZERO_BYTES, stream);
    Args a{};
    for (int i = 0; i < 21; ++i) a.in[i] = (const float*)d_in[i];
    a.out = (float*)d_out; a.ws = (unsigned char*)d_ws;
#if ONE_LAUNCH
    a.ph_lo = 0; a.ph_hi = NSTEPS;
    hipLaunchKernelGGL(fwd_kernel, dim3(grid), dim3(NTHR), LDS_BYTES, stream, a);
#else
    for (int s = 0; s < NSTEPS; ++s) { a.ph_lo = s; a.ph_hi = s + 1; hipLaunchKernelGGL(fwd_kernel, dim3(grid), dim3(NTHR), LDS_BYTES, stream, a); }
#endif
}
```

```cpp
#include <hip/hip_runtime.h>
#include <cstdio>
#include <cstdint>
#include <cmath>

#ifndef MOE_F8_MASK
#define MOE_F8_MASK 3
#endif
#ifndef DENSE_UP8_MASK
#define DENSE_UP8_MASK 3
#endif
#ifndef DENSE_F8_MASK
#define DENSE_F8_MASK 2
#endif
#define F8_SW 64.0f
#define F8_SACT 8.0f
#define DFT_SA 16384.0f
#define DFT_SY 16.0f
#ifndef PROL_A
#define PROL_A 0
#define PROL_C 0
#endif
#ifndef ONE_LAUNCH
#define ONE_LAUNCH 1
#endif

#define LAS __attribute__((address_space(3)))
#define GAS __attribute__((address_space(1)))
typedef unsigned short bf16_t;
typedef short bf16x8 __attribute__((ext_vector_type(8)));
typedef short s16x4 __attribute__((ext_vector_type(4)));
typedef float f32x4 __attribute__((ext_vector_type(4)));
typedef float f32x2 __attribute__((ext_vector_type(2)));
typedef unsigned u32x4 __attribute__((ext_vector_type(4)));
typedef unsigned u32x2 __attribute__((ext_vector_type(2)));
typedef __bf16 bf16x2_t __attribute__((ext_vector_type(2)));
typedef int i32x8 __attribute__((ext_vector_type(8)));
typedef int i32x4 __attribute__((ext_vector_type(4)));

constexpr int DM = 1024, NTOK = 32768, SEQ = 4096, NBATCH = 8, DEPTH = 4;
constexpr int SRC_IN = 8704;
constexpr int INW = 9216;
constexpr int QKVW = 4608;
constexpr int FF = 2816, NE = 8, ED = 3584;
constexpr float RMS_EPS = 1e-6f;
constexpr int NWAVES = 8, NTHR = 512;

constexpr size_t MiB = 1u << 20;
constexpr size_t WS_CTL = 0, CTL_ZERO_BYTES = 1 * MiB;
constexpr size_t WS_RINFO = 1 * MiB;
constexpr size_t WS_DS = 8 * MiB;
constexpr size_t WS_T2048 = 44 * MiB;
constexpr size_t WS_WIN = 72 * MiB;
constexpr size_t WIN_SLOT = 18 * MiB, WIN_SW = 8 * MiB, WIN_F = 10 * MiB;
constexpr size_t WS_WB = 144 * MiB;
constexpr size_t WS_WO = 156 * MiB;
constexpr size_t W13_SLOT = 11 * MiB, W13_SW = 6 * MiB;
constexpr size_t WS_W13 = 164 * MiB;
constexpr size_t WS_W2 = 186 * MiB;
constexpr size_t WS_H = 200 * MiB;
constexpr size_t H_SH = 32 * MiB;
constexpr size_t WS_QKV = 264 * MiB;
constexpr size_t WS_HF = 552 * MiB;
constexpr size_t WS_UP = 616 * MiB;
constexpr size_t WS_GATES = 648 * MiB;
constexpr size_t WS_OG = 840 * MiB;
constexpr size_t WS_YT = 936 * MiB;
constexpr size_t WS_PD = 1000 * MiB;
constexpr size_t WS_LSE = 1032 * MiB;
constexpr size_t WS_END = 1034 * MiB;
constexpr size_t WS_ATTN = 264 * MiB;
constexpr size_t WS_FOUR = 296 * MiB;
constexpr size_t WS_MERGED = 328 * MiB;
constexpr size_t WS_SLAB = 456 * MiB;
constexpr size_t WS_ACT = 264 * MiB;
constexpr size_t WS_XB = 744 * MiB;
constexpr size_t WS_WM2 = 838 * MiB;
constexpr size_t WS_Y1 = 894 * MiB;
static_assert(WS_Y1 + (size_t)NTOK * DM * 2 <= WS_END, "ws map");
constexpr int CW_TMO = 0;
constexpr int CW_BAR = 4096;
constexpr int CW_GCNT = 8192;
constexpr int CW_GRAN = 16384;
constexpr int CW_TAIL = 12288;
constexpr int MOE_KS = 7, MOE_TAIL_MAX = 64;

constexpr int LDS_BYTES = 147456;
constexpr int AT_K = 0, AT_V = 65536;
constexpr int BT_OFF = 135168;
constexpr int MISC_OFF = 142848;

#define LDS_WAIT() asm volatile("s_waitcnt lgkmcnt(0)" ::: "memory")
#define VM_WAIT() asm volatile("s_waitcnt vmcnt(0)" ::: "memory")
__device__ __forceinline__ unsigned pk2(float lo, float hi) { f32x2 v = {lo, hi}; bf16x2_t r = __builtin_convertvector(v, bf16x2_t); return __builtin_bit_cast(unsigned, r); }
__device__ __forceinline__ float clamp8(float v) { return __builtin_amdgcn_fmed3f(v, -448.0f, 448.0f); }
__device__ __forceinline__ unsigned pk8x4(float a, float b, float c, float d) {
    int p = __builtin_amdgcn_cvt_pk_fp8_f32(clamp8(a), clamp8(b), 0, false); p = __builtin_amdgcn_cvt_pk_fp8_f32(clamp8(c), clamp8(d), p, true); return (unsigned)p; }
__device__ __forceinline__ unsigned pk8x4_nc(float a, float b, float c, float d) {
    int p = __builtin_amdgcn_cvt_pk_fp8_f32(a, b, 0, false); p = __builtin_amdgcn_cvt_pk_fp8_f32(c, d, p, true); return (unsigned)p; }
__device__ __forceinline__ float bf_lo(unsigned u) { return __uint_as_float(u << 16); }
__device__ __forceinline__ float bf_hi(unsigned u) { return __uint_as_float(u & 0xffff0000u); }
template <bool BF> __device__ __forceinline__ f32x4 ldx4(const void* p, size_t i4) {
    if constexpr (BF) { const u32x2 w = ((const u32x2*)p)[i4]; return (f32x4){bf_lo(w.x), bf_hi(w.x), bf_lo(w.y), bf_hi(w.y)}; }
    else return ((const f32x4*)p)[i4];
}
template <bool BF> __device__ __forceinline__ void ldx8(const void* p, size_t i8, f32x4& a, f32x4& b) {
    if constexpr (BF) { const u32x4 w = ((const u32x4*)p)[i8]; a = (f32x4){bf_lo(w.x), bf_hi(w.x), bf_lo(w.y), bf_hi(w.y)}; b = (f32x4){bf_lo(w.z), bf_hi(w.z), bf_lo(w.w), bf_hi(w.w)}; }
    else { a = ((const f32x4*)p)[2 * i8]; b = ((const f32x4*)p)[2 * i8 + 1]; }
}
__device__ __forceinline__ void stx8(bf16_t* p, size_t i8, const f32x4 a, const f32x4 b) { u32x4 w; w.x = pk2(a.x, a.y); w.y = pk2(a.z, a.w); w.z = pk2(b.x, b.y); w.w = pk2(b.z, b.w); ((u32x4*)p)[i8] = w; }
__device__ __forceinline__ void stx8_wt(bf16_t* base, size_t i8, const f32x4 a, const f32x4 b) {
    u32x4 w; w.x = pk2(a.x, a.y); w.y = pk2(a.z, a.w); w.z = pk2(b.x, b.y); w.w = pk2(b.z, b.w);
    const __amdgpu_buffer_rsrc_t rs = __builtin_amdgcn_make_buffer_rsrc((void*)base, (short)0, 0x7fffffff, 0x00020000);
    __builtin_amdgcn_raw_buffer_store_b128(w, rs, (unsigned)(i8 * 16), 0, 16); }
__device__ __forceinline__ void stx4(bf16_t* p, size_t i4, const f32x4 v) { u32x2 w; w.x = pk2(v.x, v.y); w.y = pk2(v.z, v.w); ((u32x2*)p)[i4] = w; }
__device__ __forceinline__ float wave_sum(float v) {
#pragma unroll
    for (int o = 1; o < 64; o <<= 1) v += __shfl_xor(v, o);
    return v;
}
__device__ __forceinline__ float fast_exp(float x) { return __builtin_amdgcn_exp2f(x * 1.4426950408889634f); }
__device__ __forceinline__ float sigmoidf_(float x) { return __builtin_amdgcn_rcpf(1.0f + fast_exp(-x)); }

#define XB_TMO      128
#define XB_XCNT(j)  (256  + 64 * (j))
#define XB_XSUB(j)  (1280 + 64 * (j))
#define XB_XGEN(j)  (2304 + 64 * (j))
#define XB_TOP      3328
#define XB_TOPGEN   3392
#define XCD_BAR_WORDS 3456
#define XB_SPIN_CAP (1u << 18)
__device__ __forceinline__ unsigned xb_ld(unsigned* p)              { return __hip_atomic_load(p, __ATOMIC_RELAXED, __HIP_MEMORY_SCOPE_AGENT); }
__device__ __forceinline__ unsigned xb_add(unsigned* p, unsigned v) { return __hip_atomic_fetch_add(p, v, __ATOMIC_RELAXED, __HIP_MEMORY_SCOPE_AGENT); }
__device__ __forceinline__ unsigned xb_xcc_id() { return (unsigned)__builtin_amdgcn_s_getreg((3 << 11) | 20) & 0xFu; }
#define XB_SPIN(cond, bar) do { unsigned _sp = 0; while (cond) { __builtin_amdgcn_s_sleep(1); \
    if ((++_sp & 255u) == 0u) { if (xb_ld(&(bar)[XB_TMO])) break; if (_sp > XB_SPIN_CAP) { atomicAdd(&(bar)[XB_TMO], 1u); break; } } } } while (0)
struct XcdBarrier { unsigned* bar; unsigned x; volatile LAS unsigned* st; };
__device__ __forceinline__ XcdBarrier xcd_barrier_post(unsigned* bar, volatile LAS unsigned* st) {
    XcdBarrier b; b.bar = bar; b.x = xb_xcc_id(); b.st = st;
    if (threadIdx.x == 0) (void)xb_add(&bar[XB_XCNT(b.x)], 1u);
    return b;
}
__device__ __forceinline__ void xcd_barrier_complete(unsigned* bar, unsigned x, unsigned& nloc, unsigned& nx) {
    const unsigned G = gridDim.x * gridDim.y * gridDim.z;
    unsigned sum, cnt, mine, sp = 0u;
    for (;;) {
        sum = 0u; cnt = 0u; mine = 0u;
#pragma unroll
        for (unsigned j = 0; j < 16; ++j) { const unsigned c = xb_ld(&bar[XB_XCNT(j)]); sum += c; cnt += (c > 0u) ? 1u : 0u; mine = (j == x) ? c : mine; }
        if (sum == G) break;
        __builtin_amdgcn_s_sleep(1);
        if ((++sp & 255u) == 0u) { if (xb_ld(&bar[XB_TMO])) break; if (sp > XB_SPIN_CAP) { atomicAdd(&bar[XB_TMO], 1u); break; } }
    }
    nloc = mine > 0u ? mine : 1u; nx = cnt > 0u ? cnt : 1u;
}
__device__ __forceinline__ void xcd_barrier(const XcdBarrier& b) {
    asm volatile("s_waitcnt vmcnt(0)" ::: "memory");
    __syncthreads();
    if (threadIdx.x == 0) {
        unsigned* bar = b.bar;
        __builtin_amdgcn_s_waitcnt(0);
        asm volatile("buffer_inv sc1" ::: "memory");
        unsigned nloc = b.st[0], nx = b.st[1];
        if (nloc == 0u) { xcd_barrier_complete(bar, b.x, nloc, nx); b.st[0] = nloc; b.st[1] = nx; }
        const unsigned old = xb_add(&bar[XB_XSUB(b.x)], 1u);
        const unsigned gen = old / nloc;
        if (old + 1u == (gen + 1u) * nloc) {
            __builtin_amdgcn_fence(__ATOMIC_RELEASE, "agent");
            asm volatile("s_waitcnt vmcnt(0)" ::: "memory");
            const unsigned og = xb_add(&bar[XB_TOP], 1u);
            const unsigned tg = og / nx;
            if (og + 1u == (tg + 1u) * nx) xb_add(&bar[XB_TOPGEN], 1u);
            else XB_SPIN(xb_ld(&bar[XB_TOPGEN]) == tg, bar);
            asm volatile("" ::: "memory");
            xb_add(&bar[XB_XGEN(b.x)], 1u);
            asm volatile("s_waitcnt vmcnt(0)" ::: "memory");
        } else {
            XB_SPIN(xb_ld(&bar[XB_XGEN(b.x)]) == gen, bar);
            asm volatile("s_waitcnt vmcnt(0)" ::: "memory");
        }
    }
    __syncthreads();
}

namespace pg8 {
constexpr int BM = 256, BK = 64, HALF = 128, HTB = HALF * BK * 2, STAGE_BYTES = 8 * HTB, NXCD = 8, WGM = 8;
__host__ __device__ __forceinline__ int lds_byte(int r, int c) { const int st = (r >> 4) * 2 + (c >> 5), rr = r & 15, cc = c & 31, ob = rr * 64 + cc * 2; return st * 1024 + (ob ^ (((ob >> 9) & 1) << 5)); }
__host__ __device__ __forceinline__ void stage_rc(int b, int& R, int& C) { const int st = b / 1024, sb = b % 1024, swz = sb ^ (((sb >> 9) & 1) << 5); R = (st >> 1) * 16 + swz / 64; C = (st & 1) * 32 + (swz % 64) / 2; }
__host__ __device__ __forceinline__ int perm32(int rho) { const int n = rho >> 4, i = rho & 15; return 8 * (i >> 2) + 4 * n + (i & 3); }

struct Unit { int pm, pn, e, lt; };
struct GemmP { int K, lda, ldb; };

struct TileMap {
    int nM, nN, nwg, G, c;
    __device__ __forceinline__ void init(int nM_, int nN_, int G_, int c_) { nM = nM_; nN = nN_; nwg = nM * nN; G = G_; c = c_; }
    __device__ __forceinline__ bool map(int i, int& pm, int& pn) const { return map_L((long)i * G + c, pm, pn); }
    __device__ __forceinline__ bool map_L(const long L, int& pm, int& pn) const {
        if (L >= nwg) return false;
        int wgid = (int)L; { const int q = nwg / NXCD, r = nwg % NXCD, xcd = wgid % NXCD, off = wgid / NXCD; wgid = (xcd < r ? xcd * (q + 1) : r * (q + 1) + (xcd - r) * q) + off; }
        const int nig = WGM * nN, gid = wgid / nig, fm = gid * WGM, gsz = (nM - fm) < WGM ? (nM - fm) : WGM;
        pm = fm + ((wgid % nig) % gsz); pn = (wgid % nig) / gsz; return true;
    }
};

template <class Epi, class Sched, int KDIM, int LDA, int LDB, bool SWAP = false, int QM = 0>
__device__ __forceinline__ void gemm_phase(LAS unsigned char* lds, const Sched& S, const Epi& E, const int tid) {
    constexpr bool GA = Sched::GATHER; constexpr bool ALIGN_EPI = true, SP2 = true; constexpr GemmP g{KDIM, LDA, LDB};
    const int wid = __builtin_amdgcn_readfirstlane(tid >> 6), lane = tid & 63, wr = wid >> 2, wc = wid & 3, fr = lane & 15, fq = lane >> 4;
    constexpr bool F8 = QM == 1, I8 = QM == 2; constexpr int ES = QM ? 1 : 2;
    const int nt = (g.K * ES) / (BK * 2);
    unsigned voffA[2][2], nvoffA[2][2], voffB[2]; int stR[2], stC[2];
#pragma unroll
    for (int i = 0; i < 2; ++i) { int R, C; stage_rc(tid * 16 + i * 8192, R, C); stR[i] = R; stC[i] = C; const int Rb = Epi::PERM ? ((R & ~31) + perm32(R & 31)) : R;
        voffA[0][i] = (unsigned)(R * g.lda * ES + C * 2); voffA[1][i] = voffA[0][i]; nvoffA[0][i] = voffA[0][i]; nvoffA[1][i] = voffA[0][i]; voffB[i] = (unsigned)(Rb * g.ldb * ES + C * 2); }
    const size_t kstep = (size_t)(BK * 2);
    const size_t hstepA = (size_t)HALF * g.lda * ES, hstepB = (size_t)HALF * g.ldb * ES;
    const unsigned ldsw = (unsigned)wid * 1024u;
    const int aoff = lds_byte(wr * 64 + fr, fq * 8), boff = lds_byte(wc * 32 + fr, fq * 8);
#define PG8_SA(b, h) (((b) * 2 + (h)) * HTB)
#define PG8_SB(b, h) ((4 + (b) * 2 + (h)) * HTB)
#define PG8_STAGE_B(bufoff, gbase) do { _Pragma("unroll") for (int _i = 0; _i < 2; ++_i) \
        __builtin_amdgcn_global_load_lds((const unsigned*)((const char*)(gbase) + voffB[_i]), (LAS unsigned*)(lds + (bufoff) + ldsw + _i * 8192), 16, 0, 0); } while (0)
#define PG8_STAGE_A(bufoff, h, gbase, vo) do { _Pragma("unroll") for (int _i = 0; _i < 2; ++_i) \
        __builtin_amdgcn_global_load_lds((const unsigned*)((const char*)(gbase) + (GA ? (size_t)0 : (size_t)(h) * hstepA) + (vo)[GA ? (h) : 0][_i]), (LAS unsigned*)(lds + (bufoff) + ldsw + _i * 8192), 16, 0, 0); } while (0)
#define PG8_LDA(dst, b, h) do { _Pragma("unroll") for (int m = 0; m < 4; ++m) _Pragma("unroll") for (int k = 0; k < 2; ++k) dst[m][k] = *(const LAS u32x4*)(lds + PG8_SA(b, h) + aoff + m * 2048 + k * 1024); } while (0)
#define PG8_LDB(dst, b, h) do { _Pragma("unroll") for (int n = 0; n < 2; ++n) _Pragma("unroll") for (int k = 0; k < 2; ++k) dst[n][k] = *(const LAS u32x4*)(lds + PG8_SB(b, h) + boff + n * 2048 + k * 1024); } while (0)
#define PG8_MMA(ai, bj, At, Bt) do { __builtin_amdgcn_s_setprio(1); if constexpr (F8) { _Pragma("unroll") for (int m = 0; m < 4; ++m) _Pragma("unroll") for (int n = 0; n < 2; ++n) \
        asm volatile("v_mfma_scale_f32_16x16x128_f8f6f4 %0, %1, %2, %0, %3, %3 op_sel_hi:[0,0,0]" : "+v"(acc[ai][bj][m][n]) \
            : "v"(__builtin_bit_cast(i32x8, __builtin_shufflevector(Bt[n][0], Bt[n][1], 0, 1, 2, 3, 4, 5, 6, 7))), "v"(__builtin_bit_cast(i32x8, __builtin_shufflevector(At[m][0], At[m][1], 0, 1, 2, 3, 4, 5, 6, 7))), "v"(0x7f7f7f7f)); } else { \
        _Pragma("unroll") for (int m = 0; m < 4; ++m) _Pragma("unroll") for (int n = 0; n < 2; ++n) _Pragma("unroll") for (int k = 0; k < 2; ++k) \
        acc[ai][bj][m][n] = I8 ? __builtin_bit_cast(f32x4, __builtin_amdgcn_mfma_i32_16x16x64_i8(__builtin_bit_cast(i32x4, Bt[n][k]), __builtin_bit_cast(i32x4, At[m][k]), __builtin_bit_cast(i32x4, acc[ai][bj][m][n]), 0, 0, 0)) : SWAP ? __builtin_amdgcn_mfma_f32_16x16x32_bf16(__builtin_bit_cast(bf16x8, At[m][k]), __builtin_bit_cast(bf16x8, Bt[n][k]), acc[ai][bj][m][n], 0, 0, 0) \
                                 : __builtin_amdgcn_mfma_f32_16x16x32_bf16(__builtin_bit_cast(bf16x8, Bt[n][k]), __builtin_bit_cast(bf16x8, At[m][k]), acc[ai][bj][m][n], 0, 0, 0); } __builtin_amdgcn_s_setprio(0); } while (0)
#define PG8_WAIT_V(n) asm volatile("s_waitcnt vmcnt(" #n ")" ::: "memory")
#define PG8_WAIT_V8E asm volatile("s_waitcnt vmcnt(%0)" :: "i"(8 + Epi::NST) : "memory")
#define PG8_WAIT_L(n) asm volatile("s_waitcnt lgkmcnt(" #n ")" ::: "memory")
#define PG8_BAR __builtin_amdgcn_s_barrier()
#define PG8_SCHED __builtin_amdgcn_sched_barrier(0)
#define PG8_SCHED8 do { if constexpr (F8) __builtin_amdgcn_sched_barrier(0); } while (0)
    Unit cur, nxt; int ui = 0;
    if (!S.next(0, cur)) return;
    f32x4 acc[2][2][4][2];
#pragma unroll
    for (int a = 0; a < 2; ++a)
#pragma unroll
        for (int b = 0; b < 2; ++b)
#pragma unroll
            for (int m = 0; m < 4; ++m)
#pragma unroll
                for (int n = 0; n < 2; ++n) acc[a][b][m][n] = (f32x4){0.f, 0.f, 0.f, 0.f};
    u32x4 At[4][2], B0[2][2], B1[2][2];
    const char* cA = S.a_ptr(cur); const char* cB = S.b_ptr(cur);
    if constexpr (GA) S.a_offs(cur, stR, stC, voffA);
    static_assert(SP2, "only the SP2 loop is kept");
    PG8_STAGE_B(PG8_SB(0, 0), cB); PG8_STAGE_B(PG8_SB(0, 1), cB + hstepB); PG8_STAGE_A(PG8_SA(0, 0), 0, cA, voffA); PG8_STAGE_A(PG8_SA(0, 1), 1, cA, voffA);
    if (wr == 1) PG8_BAR;
    PG8_WAIT_V(2); PG8_BAR;
    PG8_STAGE_B(PG8_SB(1, 0), cB + kstep); PG8_STAGE_A(PG8_SA(1, 0), 0, cA + kstep, voffA); PG8_STAGE_B(PG8_SB(1, 1), cB + hstepB + kstep);
    if constexpr (Epi::NST > 0) { PG8_WAIT_V(0); } else { PG8_WAIT_V(6); }
    PG8_BAR;
    for (;;) {
        const bool has_next = S.next(ui + 1, nxt);
        const char* nA = has_next ? S.a_ptr(nxt) : cA; const char* nB = has_next ? S.b_ptr(nxt) : cB;
        if constexpr (GA) { if (has_next) S.a_offs(nxt, stR, stC, nvoffA); else {
#pragma unroll
            for (int h = 0; h < 2; ++h)
#pragma unroll
                for (int i = 0; i < 2; ++i) nvoffA[h][i] = voffA[h][i]; } }
#define PG8_TRIP(t, WA) do { \
            const bool last = ((t) == nt - 2); \
            const char* a1 = cA + (size_t)((t) + 1) * kstep; \
            const char* a2 = last ? nA : cA + (size_t)((t) + 2) * kstep; const char* b2 = last ? nB : cB + (size_t)((t) + 2) * kstep; \
            const char* a3 = a2 + kstep; const char* b3 = b2 + kstep; \
            unsigned v2[2][2]; \
            _Pragma("unroll") for (int h = 0; h < 2; ++h) _Pragma("unroll") for (int i = 0; i < 2; ++i) v2[h][i] = (GA && last) ? nvoffA[h][i] : voffA[h][i]; \
            PG8_LDB(B0, 0, 0); PG8_LDB(B1, 0, 1); PG8_SCHED; PG8_LDA(At, 0, 0); PG8_STAGE_A(PG8_SA(1, 1), 1, a1, voffA); \
            WA; PG8_WAIT_L(0); PG8_BAR; PG8_SCHED8; PG8_MMA(0, 0, At, B0); PG8_MMA(0, 1, At, B1); PG8_SCHED8; PG8_BAR; PG8_SCHED; \
            PG8_LDA(At, 0, 1); PG8_STAGE_B(PG8_SB(0, 0), b2); PG8_STAGE_B(PG8_SB(0, 1), b2 + hstepB); PG8_STAGE_A(PG8_SA(0, 0), 0, a2, v2); \
            WA; PG8_WAIT_L(0); PG8_BAR; PG8_SCHED8; PG8_MMA(1, 0, At, B0); PG8_MMA(1, 1, At, B1); PG8_SCHED8; PG8_BAR; PG8_SCHED; \
            PG8_LDB(B0, 1, 0); PG8_LDB(B1, 1, 1); PG8_SCHED; PG8_LDA(At, 1, 0); PG8_STAGE_A(PG8_SA(0, 1), 1, a2, v2); \
            PG8_WAIT_V(8); PG8_WAIT_L(0); PG8_BAR; PG8_SCHED8; PG8_MMA(0, 0, At, B0); PG8_MMA(0, 1, At, B1); PG8_SCHED8; PG8_BAR; PG8_SCHED; \
            PG8_LDA(At, 1, 1); PG8_STAGE_B(PG8_SB(1, 0), b3); PG8_STAGE_B(PG8_SB(1, 1), b3 + hstepB); PG8_STAGE_A(PG8_SA(1, 0), 0, a3, v2); \
            PG8_WAIT_V(8); PG8_WAIT_L(0); PG8_BAR; PG8_SCHED8; PG8_MMA(1, 0, At, B0); PG8_MMA(1, 1, At, B1); PG8_SCHED8; PG8_BAR; PG8_SCHED; } while (0)
        static_assert((KDIM * ES) / (BK * 2) >= 4, "at least two trips per unit");
        if constexpr (Epi::NST > 0) { PG8_TRIP(0, PG8_WAIT_V8E); asm volatile("" : "+v"(voffB[0]), "+v"(voffB[1]), "+v"(voffA[0][0]), "+v"(voffA[0][1])); for (int t = 2; t < nt; t += 2) PG8_TRIP(t, PG8_WAIT_V(8)); }
        else { for (int t = 0; t < nt; t += 2) PG8_TRIP(t, PG8_WAIT_V(8)); }
#undef PG8_TRIP
        if constexpr (ALIGN_EPI) { if (wr == 0) PG8_BAR; }
        if constexpr (F8) asm volatile("s_nop 15\n\ts_nop 15\n\ts_nop 7" ::: "memory");
        E(acc, cur, wr, wc, fr, fq);
        if (!has_next) break;
        if (!E.keep(cur)) {
#pragma unroll
        for (int a = 0; a < 2; ++a)
#pragma unroll
            for (int b = 0; b < 2; ++b)
#pragma unroll
                for (int m = 0; m < 4; ++m)
#pragma unroll
                    for (int n = 0; n < 2; ++n) acc[a][b][m][n] = (f32x4){0.f, 0.f, 0.f, 0.f}; }
        cur = nxt; cA = nA; cB = nB; ++ui;
        if constexpr (GA) {
#pragma unroll
            for (int h = 0; h < 2; ++h)
#pragma unroll
                for (int i = 0; i < 2; ++i) voffA[h][i] = nvoffA[h][i]; }
        if constexpr (ALIGN_EPI) { if (wr == 1) PG8_BAR; }
    }
    PG8_WAIT_V(0);
    if constexpr (!ALIGN_EPI) { if (wr == 0) PG8_BAR; }
    PG8_BAR;
#undef PG8_SA
#undef PG8_SB
#undef PG8_STAGE_A
#undef PG8_STAGE_B
#undef PG8_LDA
#undef PG8_LDB
#undef PG8_MMA
#undef PG8_WAIT_V
#undef PG8_WAIT_V8E
#undef PG8_WAIT_L
#undef PG8_BAR
#undef PG8_SCHED
#undef PG8_SCHED8
}

struct SchedPlain {
    static constexpr bool GATHER = false;
    TileMap tm; const char* A; const char* Bt; size_t astep, bstep;
    __device__ __forceinline__ void init(const void* A_, int lda, const void* Bt_, int ldb, int M, int N, int G, int c, int es = 2) { tm.init(M / BM, N / BM, G, c); A = (const char*)A_; Bt = (const char*)Bt_; astep = (size_t)BM * lda * es; bstep = (size_t)BM * ldb * es; }
    __device__ __forceinline__ bool next(int i, Unit& u) const { u.e = 0; u.lt = 0; return tm.map(i, u.pm, u.pn); }
    __device__ __forceinline__ const char* a_ptr(const Unit& u) const { return A + (size_t)u.pm * astep; }
    __device__ __forceinline__ const char* b_ptr(const Unit& u) const { return Bt + (size_t)u.pn * bstep; }
};
struct SchedIn {
    static constexpr bool GATHER = false;
    TileMap tm; const char* A; const char* Bt;
    __device__ __forceinline__ bool next(int i, Unit& u) const { u.e = 0; u.lt = 0; return tm.map(i, u.pm, u.pn); }
    __device__ __forceinline__ const char* a_ptr(const Unit& u) const { return A + (size_t)u.pm * 256 * 1024; }
    __device__ __forceinline__ const char* b_ptr(const Unit& u) const { return Bt + (size_t)u.pn * 256 * 1024; }
};
struct SchedFour {
    static constexpr bool GATHER = false;
    const char* A; const char* Bt; int G, c;
    __device__ __forceinline__ bool next(int i, Unit& u) const { const int L = i * G + c; if (L >= 256) return false; u.pm = L >> 1; u.pn = L & 1; u.e = (L >> 4) & 1; u.lt = 0; return true; }
    __device__ __forceinline__ const char* a_ptr(const Unit& u) const { return A + (size_t)u.pm * 256 * 1024 * 2; }
    __device__ __forceinline__ const char* b_ptr(const Unit& u) const { return Bt + (size_t)(u.e * 512 + u.pn * 256) * 1024 * 2; }
};
struct SchedDFT {
    static constexpr bool GATHER = false;
    const char* DS; const char* Yt; int G, c;
    __device__ __forceinline__ bool next(int i, Unit& u) const {
        const int L = i * G + c; if (L >= 256) return false;
        const int Lx = ((L & 7) << 5) | (L >> 3);
        u.pm = Lx >> 5; u.lt = (Lx >> 4) & 1; u.e = (Lx >> 1) & 7; u.pn = Lx & 1; return true;
    }
    __device__ __forceinline__ const char* a_ptr(const Unit& u) const { return DS + ((size_t)u.pm * 256 * 4096 + (size_t)u.lt * 2048); }
    __device__ __forceinline__ const char* b_ptr(const Unit& u) const { return Yt + (((size_t)u.e * 512 + (size_t)u.pn * 256) * 4096 + (size_t)u.lt * 2048); }
};
struct SchedBranch {
    static constexpr bool GATHER = false;
    TileMap tm; const char* ws; const char* W;
    __device__ __forceinline__ bool next(int i, Unit& u) const { u.e = i % 3; u.lt = 0; return tm.map(i / 3, u.pm, u.pn); }
    __device__ __forceinline__ const char* a_ptr(const Unit& u) const { const size_t off = WS_ATTN + (size_t)u.e * (WS_FOUR - WS_ATTN) + (u.e == 2 ? (WS_PD - WS_ATTN - 2 * (WS_FOUR - WS_ATTN)) : (size_t)0); return ws + off + (size_t)u.pm * 256 * 512 * 2; }
    __device__ __forceinline__ const char* b_ptr(const Unit& u) const { return W + ((size_t)u.e * 1024 + (size_t)u.pn * 256) * 512 * 2; }
};
struct MoeTiles {
    const LAS int* t;
    __device__ __forceinline__ void locate(int pm, int& e, int& lt) const { int ee = 0;
#pragma unroll
        for (int j = 1; j < 8; ++j) ee += (pm >= t[j]) ? 1 : 0;
        ee = __builtin_amdgcn_readfirstlane(ee); e = ee; lt = pm - __builtin_amdgcn_readfirstlane(t[ee]); }
    __device__ __forceinline__ int count(int e) const { return __builtin_amdgcn_readfirstlane(t[16 + e]); }
    __device__ __forceinline__ int total() const { return __builtin_amdgcn_readfirstlane(t[8]); }
};
__device__ __forceinline__ void moe_tiles_setup(LAS int* t, const unsigned* gcnt, int tid) {
    if (tid == 0) { int s = 0;
        for (int e = 0; e < 8; ++e) { const int c = (int)__hip_atomic_load(gcnt + e, __ATOMIC_RELAXED, __HIP_MEMORY_SCOPE_AGENT); t[16 + e] = c; t[e] = s; s += (c + 255) >> 8; } t[8] = s; }
    __syncthreads();
}
template <int ES> struct SchedMoeUp {
    static constexpr bool GATHER = true;
    TileMap tm; MoeTiles mt; const char* H; const char* W13; const u32x2* rinfo;
    __device__ __forceinline__ bool next(int i, Unit& u) const { if (!tm.map(i, u.pm, u.pn)) return false; mt.locate(u.pm, u.e, u.lt); return true; }
    __device__ __forceinline__ const char* a_ptr(const Unit&) const { return H; }
    __device__ __forceinline__ const char* b_ptr(const Unit& u) const { return W13 + ((size_t)u.e * 7168 + (size_t)u.pn * 256) * 1024 * ES; }
    __device__ __forceinline__ void a_offs(const Unit& u, const int (&R)[2], const int (&C)[2], unsigned (&vo)[2][2]) const {
        const int cnt = mt.count(u.e);
#pragma unroll
        for (int h = 0; h < 2; ++h)
#pragma unroll
            for (int i = 0; i < 2; ++i) { const int slot = u.lt * 256 + h * 128 + R[i]; unsigned tok = 0u;
                if (slot < cnt) tok = rinfo[(size_t)u.e * 32768 + slot].x & 0x7fffffffu;
                vo[h][i] = tok * (unsigned)(1024 * ES) + (unsigned)C[i] * 2u; }
    }
};
template <int ES> struct SchedMoeDown {
    static constexpr bool GATHER = false;
    TileMap tm; MoeTiles mt; const char* ACT; const char* W2; int lim;
    __device__ __forceinline__ bool next(int i, Unit& u) const { if ((long)i * tm.G + tm.c >= lim) return false; if (!tm.map(i, u.pm, u.pn)) return false; mt.locate(u.pm, u.e, u.lt); return true; }
    __device__ __forceinline__ const char* a_ptr(const Unit& u) const { return ACT + (size_t)u.pm * 256 * 3584 * ES; }
    __device__ __forceinline__ const char* b_ptr(const Unit& u) const { return W2 + ((size_t)u.e * 1024 + (size_t)u.pn * 256) * 3584 * ES; }
};
template <int ES, int KS> struct SchedMoeDownTail {
    static constexpr bool GATHER = false; static constexpr int KSL = 3584 / KS;
    TileMap tm; MoeTiles mt; const char* ACT; const char* W2; int lim, ntail;
    __device__ __forceinline__ bool next(int i, Unit& u) const {
        const int upx = (tm.G >> 3) / KS, xcd = tm.c & 7, idx = tm.c >> 3; if (idx >= upx * KS) return false;
        const int ti = (i * 8 + xcd) * upx + idx / KS, ks = idx % KS; if (ti >= ntail) return false;
        tm.map_L(lim + ti, u.pm, u.pn); mt.locate(u.pm, u.e, u.lt); u.lt |= (ks << 8) | (ti << 12); return true; }
    __device__ __forceinline__ const char* a_ptr(const Unit& u) const { return ACT + ((size_t)u.pm * 256 * 3584 + (size_t)(((u.lt >> 8) & 15) * KSL)) * ES; }
    __device__ __forceinline__ const char* b_ptr(const Unit& u) const { return W2 + (((size_t)u.e * 1024 + (size_t)u.pn * 256) * 3584 + (size_t)(((u.lt >> 8) & 15) * KSL)) * ES; }
};

struct EpiIn {
    static constexpr bool PERM = true; static constexpr int NST = 0;
    __device__ __forceinline__ bool keep(const Unit&) const { return false; }
    bf16_t *QKV, *UP, *GATES; const float* qg; const float* kg; LAS float* P;
    const float* SH; const float* SW;
    __device__ __forceinline__ void operator()(f32x4 (&acc)[2][2][4][2], const Unit& u, int wr, int wc, int fr_in, int fq_in) const {
        int fr = fr_in, fq = fq_in; asm volatile("" : "+v"(fr), "+v"(fq));
        { const float* swp = SW + u.pn * 256 + wc * 32 + 8 * fq; const float* shp = SH + u.pm * BM + wr * 64 + fr;
          const float vsc = (u.pn >= 12 && u.pn < 18) ? 8.0f : 1.0f;
          const float gsc = u.pn >= 20 ? -1.4426950408889634f : 1.0f;
#pragma unroll
          for (int bj = 0; bj < 2; ++bj) { const f32x4 sw0 = *(const f32x4*)(swp + bj * HALF) * gsc, sw1 = *(const f32x4*)(swp + bj * HALF + 4) * gsc;
#pragma unroll
              for (int ai = 0; ai < 2; ++ai)
#pragma unroll
                  for (int m = 0; m < 4; ++m) { const float sa = shp[ai * HALF + m * 16] * vsc;
                      const i32x4 q0 = __builtin_bit_cast(i32x4, acc[ai][bj][m][0]), q1 = __builtin_bit_cast(i32x4, acc[ai][bj][m][1]);
                      acc[ai][bj][m][0] = (f32x4){(float)q0[0], (float)q0[1], (float)q0[2], (float)q0[3]} * sw0 * sa;
                      acc[ai][bj][m][1] = (f32x4){(float)q1[0], (float)q1[1], (float)q1[2], (float)q1[3]} * sw1 * sa; }
              asm volatile("" ::: "memory"); } }
        bf16_t* base; int ldc, colt; bool sg = false;
        if (u.pn < 18) { base = QKV; ldc = 4608; colt = u.pn * 256; }
        else if (u.pn < 20) { base = UP; ldc = 512; colt = (u.pn - 18) * 256; }
        else { base = GATES; ldc = 3072; colt = (u.pn - 20) * 256; sg = true; }
        if (u.pn < 12) {
#pragma unroll
            for (int ai = 0; ai < 2; ++ai)
#pragma unroll
                for (int m = 0; m < 4; ++m)
#pragma unroll
                    for (int bj = 0; bj < 2; ++bj) { const f32x4 a = acc[ai][bj][m][0], b = acc[ai][bj][m][1];
                        float ss = (a[0] * a[0] + a[1] * a[1]) + (a[2] * a[2] + a[3] * a[3]) + (b[0] * b[0] + b[1] * b[1]) + (b[2] * b[2] + b[3] * b[3]);
                        ss += __shfl_xor(ss, 16); ss += __shfl_xor(ss, 32);
                        if (fq == 0) P[((ai * HALF + wr * 64 + m * 16 + fr) * 2 + bj) * 4 + wc] = ss; }
            asm volatile("s_waitcnt lgkmcnt(0)" ::: "memory"); __builtin_amdgcn_s_barrier(); asm volatile("" ::: "memory");
            const float* gn = (u.pn < 6 ? qg : kg) + wc * 32 + 8 * fq; const float qs = u.pn < 6 ? 0.08838834764831845f * 64.0f : 8.0f;
            const f32x4 g0 = *(const f32x4*)gn * qs, g1 = *(const f32x4*)(gn + 4) * qs;
#pragma unroll
            for (int ai = 0; ai < 2; ++ai)
#pragma unroll
                for (int m = 0; m < 4; ++m)
#pragma unroll
                    for (int bj = 0; bj < 2; ++bj) { const f32x4 p = *(const LAS f32x4*)(P + ((ai * HALF + wr * 64 + m * 16 + fr) * 2 + bj) * 4);
                        const float rstd = __builtin_amdgcn_rsqf(((p[0] + p[1]) + (p[2] + p[3])) * (1.0f / 128.0f) + RMS_EPS);
                        acc[ai][bj][m][0] *= g0 * rstd; acc[ai][bj][m][1] *= g1 * rstd; }
        }
        const int row0 = u.pm * BM + wr * 64 + fr, col0 = colt + wc * 32 + 8 * fq;
#pragma unroll
        for (int ai = 0; ai < 2; ++ai)
#pragma unroll
            for (int m = 0; m < 4; ++m) { bf16_t* rowp = base + (size_t)(row0 + ai * HALF + m * 16) * ldc + col0;
#pragma unroll
                for (int bj = 0; bj < 2; ++bj) { f32x4 v0 = acc[ai][bj][m][0], v1 = acc[ai][bj][m][1];
                    if (sg) {
                        float y[8];
#pragma unroll
                        for (int j = 0; j < 4; ++j) {
                            y[j] = __builtin_amdgcn_rcpf(__builtin_amdgcn_fmed3f(__builtin_fmaf(__builtin_amdgcn_exp2f(v0[j]), 1.0f / 255.0f, 1.0f / 255.0f), 0.0f, 1.0f)) + 8388608.0f;
                            y[4 + j] = __builtin_amdgcn_rcpf(__builtin_amdgcn_fmed3f(__builtin_fmaf(__builtin_amdgcn_exp2f(v1[j]), 1.0f / 255.0f, 1.0f / 255.0f), 0.0f, 1.0f)) + 8388608.0f; }
                        u32x2 w;
                        w.x = __builtin_amdgcn_perm(__float_as_uint(y[1]), __float_as_uint(y[0]), 0x0c0c0400u) | __builtin_amdgcn_perm(__float_as_uint(y[3]), __float_as_uint(y[2]), 0x04000c0cu);
                        w.y = __builtin_amdgcn_perm(__float_as_uint(y[5]), __float_as_uint(y[4]), 0x0c0c0400u) | __builtin_amdgcn_perm(__float_as_uint(y[7]), __float_as_uint(y[6]), 0x04000c0cu);
                        *(u32x2*)((unsigned char*)base + ((size_t)(u.pm * 12 + (u.pn - 20)) << 16) + (size_t)((((((wr * 4 + wc) * 2 + ai) * 4 + m) * 2 + bj) << 9) + ((fq * 16 + fr) << 3))) = w;
                    } else if (u.pn < 12) { u32x2 w; w.x = pk8x4_nc(v0[0], v0[1], v0[2], v0[3]); w.y = pk8x4_nc(v1[0], v1[1], v1[2], v1[3]);
                        *(u32x2*)((unsigned char*)base + (size_t)(row0 + ai * HALF + m * 16) * ldc + col0 + bj * HALF) = w;
                    } else if (u.pn < 18) { u32x2 w; w.x = pk8x4(v0[0], v0[1], v0[2], v0[3]); w.y = pk8x4(v1[0], v1[1], v1[2], v1[3]);
                        *(u32x2*)((unsigned char*)base + (size_t)(row0 + ai * HALF + m * 16) * ldc + col0 + bj * HALF) = w;
                    } else {
                    u32x4 w; w.x = pk2(v0[0], v0[1]); w.y = pk2(v0[2], v0[3]); w.z = pk2(v1[0], v1[1]); w.w = pk2(v1[2], v1[3]);
                    *(u32x4*)(rowp + bj * HALF) = w; } } }
    }
};
struct EpiYtf {
    static constexpr bool PERM = false; static constexpr int NST = 0;
    __device__ __forceinline__ bool keep(const Unit&) const { return false; }
    unsigned char* Ytf;
    __device__ __forceinline__ void operator()(f32x4 (&acc)[2][2][4][2], const Unit& u, int wr, int wc, int fr, int fq) const {
        const int rowt = u.pm * BM, b = rowt >> 12, kbase = rowt & 4095;
        const int c0 = u.pn * 256 + wc * 32 + fr;
#pragma unroll
        for (int bj = 0; bj < 2; ++bj)
#pragma unroll
            for (int n = 0; n < 2; ++n) { unsigned char* cp = Ytf + ((size_t)b * 512 + c0 + bj * HALF + n * 16) * 4096 + kbase + wr * 64 + 4 * fq;
#pragma unroll
                for (int ai = 0; ai < 2; ++ai)
#pragma unroll
                    for (int m = 0; m < 4; ++m) { const f32x4 v = acc[ai][bj][m][n] * DFT_SY; *(unsigned*)(cp + ai * HALF + m * 16) = pk8x4(v[0], v[1], v[2], v[3]); } }
    }
};
struct EpiDFT {
    static constexpr bool PERM = true; static constexpr int NST = 16;
    __device__ __forceinline__ bool keep(const Unit&) const { return false; }
    bf16_t* P;
    __device__ __forceinline__ void operator()(f32x4 (&acc)[2][2][4][2], const Unit& u, int wr, int wc, int fr, int fq) const {
        const int row0 = (u.lt * 8 + u.e) * 2048 + u.pm * BM + wr * 64 + fr, col0 = u.pn * 256 + wc * 32 + 8 * fq;
#pragma unroll
        for (int ai = 0; ai < 2; ++ai)
#pragma unroll
            for (int m = 0; m < 4; ++m) { bf16_t* rowp = P + (size_t)(row0 + ai * HALF + m * 16) * 512 + col0;
#pragma unroll
                for (int bj = 0; bj < 2; ++bj) { (void)rowp; stx8_wt(P, ((size_t)(row0 + ai * HALF + m * 16) * 512 + col0 + bj * HALF) >> 3, acc[ai][bj][m][0] * (1.0f / (DFT_SA * DFT_SY)), acc[ai][bj][m][1] * (1.0f / (DFT_SA * DFT_SY))); } }
    }
};
__device__ __forceinline__ f32x4 ub4(unsigned w) { return (f32x4){(float)(w & 0xffu), (float)((w >> 8) & 0xffu), (float)((w >> 16) & 0xffu), (float)(w >> 24)}; }
struct EpiBranch {
    static constexpr bool PERM = true; static constexpr int NST = 16;
    const unsigned char* GATES; bf16_t* MERGED;
    __device__ __forceinline__ bool keep(const Unit& u) const { return u.e < 2; }
    __device__ __forceinline__ void operator()(f32x4 (&acc)[2][2][4][2], const Unit& u, int wr, int wc, int fr, int fq) const {
        const int row0 = u.pm * BM + wr * 64 + fr, col0 = u.pn * BM + wc * 32 + 8 * fq;
#pragma unroll
        for (int ai = 0; ai < 2; ++ai)
#pragma unroll
            for (int m = 0; m < 4; ++m) { const size_t row = (size_t)(row0 + ai * HALF + m * 16);
                const unsigned char* gp = GATES + ((size_t)(u.pm * 12 + u.e * 4 + u.pn) << 16) + (size_t)(((((wr * 4 + wc) * 2 + ai) * 4 + m) << 10) + ((fq * 16 + fr) << 3));
                if (u.e < 2) {
#pragma unroll
                    for (int bj = 0; bj < 2; ++bj) { const u32x2 ga = *(const u32x2*)(gp + bj * 512), gb = *(const u32x2*)(gp + 4 * 65536 + bj * 512);
                        const f32x4 a0 = ub4(ga.x), a1 = ub4(ga.y), b0 = ub4(gb.x), b1 = ub4(gb.y);
                        f32x4 r0, r1;
#pragma unroll
                        for (int j = 0; j < 4; ++j) { r0[j] = a0[j] * __builtin_amdgcn_rcpf(b0[j]); r1[j] = a1[j] * __builtin_amdgcn_rcpf(b1[j]); }
                        acc[ai][bj][m][0] *= r0; acc[ai][bj][m][1] *= r1; }
                } else { bf16_t* mp = MERGED + row * 1024 + col0;
#pragma unroll
                    for (int bj = 0; bj < 2; ++bj) { const u32x2 ga = *(const u32x2*)(gp + bj * 512);
                        const f32x4 v0 = acc[ai][bj][m][0] * ub4(ga.x) * (1.0f / 255.0f), v1 = acc[ai][bj][m][1] * ub4(ga.y) * (1.0f / 255.0f);
                        (void)mp; stx8_wt(MERGED, (row * 1024 + col0 + bj * HALF) >> 3, v0, v1); } }
                asm volatile("" ::: "memory"); }
    }
};
template <bool BASE_BF> struct EpiRes {
    static constexpr bool PERM = true; static constexpr int NST = 32;
    __device__ __forceinline__ bool keep(const Unit&) const { return false; }
    const void* base; bf16_t* out; float sc;
    __device__ __forceinline__ void operator()(f32x4 (&acc)[2][2][4][2], const Unit& u, int wr, int wc, int fr, int fq) const {
        const int row0 = u.pm * BM + wr * 64 + fr, col0 = u.pn * BM + wc * 32 + 8 * fq;
#pragma unroll
        for (int ai = 0; ai < 2; ++ai)
#pragma unroll
            for (int m = 0; m < 4; ++m) { const size_t off = (size_t)(row0 + ai * HALF + m * 16) * 1024 + col0;
#pragma unroll
                for (int bj = 0; bj < 2; ++bj) { const size_t i8 = (off + bj * HALF) >> 3; f32x4 b0, b1; ldx8<BASE_BF>(base, i8, b0, b1); stx8_wt(out, i8, b0 + acc[ai][bj][m][0] * sc, b1 + acc[ai][bj][m][1] * sc); } }
    }
};
template <bool F8, bool IN8 = false> struct EpiSwiglu {
    static constexpr bool PERM = true; static constexpr int NST = IN8 ? 0 : 8;
    __device__ __forceinline__ bool keep(const Unit&) const { return false; }
    void* ACT; int ldc; float sin, sout; const float* SH; const float* SW;
    __device__ __forceinline__ void operator()(f32x4 (&acc)[2][2][4][2], const Unit& u, int wr, int wc, int fr_in, int fq_in) const {
        int fr = fr_in, fq = fq_in; asm volatile("" : "+v"(fr), "+v"(fq));
        const int row0 = u.pm * BM + wr * 64 + fr, col0 = u.pn * 128 + wc * 32 + 8 * fq;
        f32x4 sw[2][2];
        if constexpr (IN8) { const float* swp = SW + u.pn * 256 + wc * 32 + 8 * fq;
#pragma unroll
            for (int bj = 0; bj < 2; ++bj) { sw[bj][0] = *(const f32x4*)(swp + bj * HALF); sw[bj][1] = *(const f32x4*)(swp + bj * HALF + 4); }
            sw[1][0] *= sw[0][0]; sw[1][1] *= sw[0][1]; sw[0][0] *= -1.4426950408889634f; sw[0][1] *= -1.4426950408889634f; }
#pragma unroll
        for (int ai = 0; ai < 2; ++ai)
#pragma unroll
            for (int m = 0; m < 4; ++m) { const size_t eo = (size_t)(row0 + ai * HALF + m * 16) * ldc + col0;
                float o[8]; float sa = 1.0f, sa2 = 1.0f; if constexpr (IN8) { sa = SH[row0 + ai * HALF + m * 16]; sa2 = sa * sa * sout; }
#pragma unroll
                for (int n = 0; n < 2; ++n)
#pragma unroll
                    for (int j = 0; j < 4; ++j) {
                        if constexpr (IN8) { const float f0 = (float)__builtin_bit_cast(i32x4, acc[ai][0][m][n])[j], f1 = (float)__builtin_bit_cast(i32x4, acc[ai][1][m][n])[j];
                            o[n * 4 + j] = (f0 * f1) * sw[1][n][j] * sa2 * __builtin_amdgcn_rcpf(1.0f + __builtin_amdgcn_exp2f(f0 * sw[0][n][j] * sa)); }
                        else { const float a0 = acc[ai][0][m][n][j], b0 = acc[ai][1][m][n][j];
                            o[n * 4 + j] = (a0 * b0) * (sin * sin * sout) * __builtin_amdgcn_rcpf(1.0f + __builtin_amdgcn_exp2f(a0 * (sin * -1.4426950408889634f))); } }
                if constexpr (F8) { u32x2 w; w.x = pk8x4(o[0], o[1], o[2], o[3]); w.y = pk8x4(o[4], o[5], o[6], o[7]); *(u32x2*)((unsigned char*)ACT + eo) = w; }
                else { u32x4 w; w.x = pk2(o[0], o[1]); w.y = pk2(o[2], o[3]); w.z = pk2(o[4], o[5]); w.w = pk2(o[6], o[7]); *(u32x4*)((bf16_t*)ACT + eo) = w; } }
    }
};
struct EpiMoeDown {
    static constexpr bool PERM = true; static constexpr int NST = 0;
    __device__ __forceinline__ bool keep(const Unit&) const { return false; }
    bf16_t* x; bf16_t* y1; const u32x2* rinfo; MoeTiles mt; float sc; unsigned rmask = 0xffu;
    __device__ __forceinline__ void operator()(f32x4 (&acc)[2][2][4][2], const Unit& u, int wr, int wc, int fr, int fq) const {
        const int cnt = mt.count(u.e);
        const int col0 = u.pn * BM + wc * 32 + 8 * fq;
#pragma unroll
        for (int ai = 0; ai < 2; ++ai)
#pragma unroll
            for (int m = 0; m < 4; ++m) { const int slot = u.lt * 256 + ai * HALF + wr * 64 + m * 16 + fr;
                if (((rmask >> (ai * 4 + m)) & 1u) && slot < cnt) { const u32x2 ri = rinfo[(size_t)u.e * 32768 + slot]; const unsigned tok = ri.x & 0x7fffffffu; const bool k1 = (ri.x >> 31) != 0u; const float gt = __uint_as_float(ri.y) * sc;
                    const size_t off = (size_t)tok * 1024 + col0;
#pragma unroll
                    for (int bj = 0; bj < 2; ++bj) { const f32x4 v0 = acc[ai][bj][m][0] * gt, v1 = acc[ai][bj][m][1] * gt; const size_t i8 = (off + bj * HALF) >> 3;
                            if (k1) stx8_wt(y1, i8, v0, v1);
                            else { f32x4 b0, b1; ldx8<true>(x, i8, b0, b1); stx8_wt(x, i8, b0 + v0, b1 + v1); } } } }
    }
};
template <int KS> struct EpiMoeDownTail {
    static constexpr bool PERM = true; static constexpr int NST = 0;
    __device__ __forceinline__ bool keep(const Unit&) const { return false; }
    EpiMoeDown inner; float* slab; unsigned* cnt; LAS int* flag;
    __device__ __forceinline__ void operator()(f32x4 (&acc)[2][2][4][2], const Unit& u, int wr, int wc, int fr, int fq) const {
        const int ks = (u.lt >> 8) & 15, ti = u.lt >> 12, wave = wr * 4 + wc, lane = fq * 16 + fr;
        const __amdgpu_buffer_rsrc_t rs = __builtin_amdgcn_make_buffer_rsrc((void*)slab, (short)0, (int)(MOE_TAIL_MAX * KS * 262144), 0x00020000);
        { const unsigned wo = ((unsigned)(ti * KS + ks) * 8u + (unsigned)wave) * 32768u + (unsigned)lane * 16u;
#pragma unroll
          for (int j = 0; j < 32; ++j) __builtin_amdgcn_raw_buffer_store_b128(__builtin_bit_cast(u32x4, acc[j >> 4][(j >> 3) & 1][(j >> 1) & 3][j & 1]), rs, wo + (unsigned)j * 1024u, 0, 16); }
        asm volatile("s_waitcnt vmcnt(0)" ::: "memory");
        __syncthreads();
        if (threadIdx.x == 0) {
            (void)__hip_atomic_fetch_add(cnt + ti, 1u, __ATOMIC_RELAXED, __HIP_MEMORY_SCOPE_AGENT);
            unsigned sp = 0u;
            while (__hip_atomic_load(cnt + ti, __ATOMIC_RELAXED, __HIP_MEMORY_SCOPE_AGENT) < (unsigned)KS) { __builtin_amdgcn_s_sleep(1); if (++sp > (1u << 22)) break; }
            __builtin_amdgcn_fence(__ATOMIC_ACQUIRE, "agent"); asm volatile("s_waitcnt vmcnt(0)" ::: "memory"); }
        __syncthreads();
        const unsigned ro = ((unsigned)(ti * KS) * 8u + (unsigned)wave) * 32768u + (unsigned)lane * 16u;
        Unit v = u; v.lt = u.lt & 255;
#pragma unroll
        for (int rg = 0; rg < 8; ++rg) { if (rg % KS != ks) continue;
            const int ai = rg >> 2, m = rg & 3; f32x4 sm[4];
#pragma unroll
            for (int q = 0; q < 4; ++q) { const unsigned jo = (unsigned)(ai * 16 + (q >> 1) * 8 + m * 2 + (q & 1)) * 1024u;
                sm[q] = __builtin_bit_cast(f32x4, __builtin_amdgcn_raw_buffer_load_b128(rs, ro + jo, 0, 16));
#pragma unroll
                for (int k2 = 1; k2 < KS; ++k2) sm[q] += __builtin_bit_cast(f32x4, __builtin_amdgcn_raw_buffer_load_b128(rs, ro + (unsigned)k2 * 262144u + jo, 0, 16)); }
            asm volatile("" : "+v"(sm[0]), "+v"(sm[1]), "+v"(sm[2]), "+v"(sm[3]) :: "memory");
            f32x4 a2[2][2][4][2]; a2[ai][0][m][0] = sm[0]; a2[ai][0][m][1] = sm[1]; a2[ai][1][m][0] = sm[2]; a2[ai][1][m][1] = sm[3];
            EpiMoeDown in2 = inner; in2.rmask = 1u << rg; in2(a2, v, wr, wc, fr, fq); }
    }
};
}

struct Args {
    const float* in[21];
    float* out; unsigned char* ws;
    int ph_lo, ph_hi;
};
typedef const __attribute__((address_space(4))) Args CArgs;
__device__ __forceinline__ Args load_args(CArgs* ap) { Args a;
#pragma unroll
    for (int i = 0; i < 21; ++i) a.in[i] = ap->in[i];
    a.out = ap->out; a.ws = ap->ws; a.ph_lo = ap->ph_lo; a.ph_hi = ap->ph_hi; return a; }
enum { I_X = 0, I_NMG, I_WIN, I_QG, I_KG, I_RELB, I_POOLW, I_POOLS, I_WBA, I_WBF, I_WBP, I_WOUT, I_NFG, I_W1, I_W3, I_W2, I_RW, I_RB, I_MW1, I_MW3, I_MW2 };

__device__ __forceinline__ void cvt_item(const float* src, int ldsrc, int k0, int c0, bf16_t* dst, int ldd, int r0, LAS float* scr, int lane) {
#pragma unroll 8
    for (int i = 0; i < 32; ++i) { const int kk = 2 * i + (lane >> 5); scr[kk * 33 + (lane & 31)] = src[(size_t)(k0 + kk) * ldsrc + c0 + (lane & 31)]; }
    LDS_WAIT(); asm volatile("" ::: "memory");
    const int c = lane & 7;
#pragma unroll
    for (int j = 0; j < 4; ++j) { const int n = (lane >> 3) + 8 * j; const LAS float* s = scr + (8 * c) * 33 + n;
        u32x4 o; o.x = pk2(s[0 * 33], s[1 * 33]); o.y = pk2(s[2 * 33], s[3 * 33]); o.z = pk2(s[4 * 33], s[5 * 33]); o.w = pk2(s[6 * 33], s[7 * 33]);
        *(u32x4*)(dst + (size_t)(r0 + n) * ldd + k0 + 8 * c) = o; }
    LDS_WAIT(); asm volatile("" ::: "memory");
}
__device__ __forceinline__ void cvt_plain(const float* src, int ldsrc, int K, bf16_t* dst, int row0, int nrows, int coff, LAS float* scr, int gw, int NGW, int lane) {
    const int nblk = nrows / 32, items = (K / 64) * nblk;
    for (int it = gw; it < items; it += NGW) { const int kb = it / nblk, nb = it % nblk; const int r0 = row0 + nb * 32; cvt_item(src, ldsrc, kb * 64, r0 + coff, dst, K, r0, scr, lane); }
}
__device__ __forceinline__ void cvt_w13(const float* w1, const float* w3, int ncol, int nmat, bf16_t* dst, LAS float* scr, int gw, int NGW, int lane) {
    const int nblk = (2 * ncol) / 32, per = 16 * nblk, items = per * nmat;
    for (int it = gw; it < items; it += NGW) { const int e = it / per, r = it % per, kb = r / nblk, nb = r % nblk; const int r0 = nb * 32; const int s = (r0 >> 7) & 1, c0 = (r0 >> 8) * 128 + (r0 & 127);
        cvt_item((s ? w3 : w1) + (size_t)e * 1024 * ncol, ncol, kb * 64, c0, dst + (size_t)e * 2 * ncol * 1024, 1024, r0, scr, lane); }
}

__device__ __forceinline__ void cvt_item8(const float* src, int ldsrc, int k0, int c0, unsigned char* dst, int ldd, int r0, float sc, LAS float* scr, int lane) {
#pragma unroll 8
    for (int i = 0; i < 32; ++i) { const int kk = 2 * i + (lane >> 5); scr[kk * 33 + (lane & 31)] = src[(size_t)(k0 + kk) * ldsrc + c0 + (lane & 31)]; }
    LDS_WAIT(); asm volatile("" ::: "memory");
    const int c = lane & 7;
#pragma unroll
    for (int j = 0; j < 4; ++j) { const int n = (lane >> 3) + 8 * j; const LAS float* s = scr + (8 * c) * 33 + n;
        u32x2 o; o.x = pk8x4(s[0 * 33] * sc, s[1 * 33] * sc, s[2 * 33] * sc, s[3 * 33] * sc); o.y = pk8x4(s[4 * 33] * sc, s[5 * 33] * sc, s[6 * 33] * sc, s[7 * 33] * sc);
        *(u32x2*)(dst + (size_t)(r0 + n) * ldd + k0 + 8 * c) = o; }
    LDS_WAIT(); asm volatile("" ::: "memory");
}
__device__ __forceinline__ void cvt_plain8(const float* src, int ldsrc, int K, unsigned char* dst, int nrows, float sc, LAS float* scr, int gw, int NGW, int lane) {
    const int nblk = nrows / 32, items = (K / 64) * nblk;
    for (int it = gw; it < items; it += NGW) { const int kb = it / nblk, nb = it % nblk; cvt_item8(src, ldsrc, kb * 64, nb * 32, dst, K, nb * 32, sc, scr, lane); }
}
__device__ __forceinline__ void cvt_w13_8(const float* w1, const float* w3, int ncol, int nmat, unsigned char* dst, float sc, LAS float* scr, int gw, int NGW, int lane) {
    const int nblk = (2 * ncol) / 32, per = 16 * nblk, items = per * nmat;
    for (int it = gw; it < items; it += NGW) { const int e = it / per, r = it % per, kb = r / nblk, nb = r % nblk; const int r0 = nb * 32; const int s = (r0 >> 7) & 1, c0 = (r0 >> 8) * 128 + (r0 & 127);
        cvt_item8((s ? w3 : w1) + (size_t)e * 1024 * ncol, ncol, kb * 64, c0, dst + (size_t)e * 2 * ncol * 1024, 1024, r0, sc, scr, lane); }
}

__device__ __forceinline__ void w8_strip(const float* src, int ld, signed char* W8r0, float* SWr0, LAS float* smax, int wave, int lane) {
    const int n = lane & 31, kh = lane >> 5;
    const float* p = src + (size_t)(128 * wave + kh) * ld + n;
    float v[64];
#pragma unroll
    for (int i = 0; i < 64; ++i) v[i] = p[(size_t)(2 * i) * ld];
    float mx = 0.f;
#pragma unroll
    for (int i = 0; i < 64; ++i) mx = fmaxf(mx, fabsf(v[i]));
    mx = fmaxf(mx, __shfl_xor(mx, 32));
    if (lane < 32) smax[wave * 32 + n] = mx;
    __syncthreads();
    mx = smax[n];
#pragma unroll
    for (int w = 1; w < 8; ++w) mx = fmaxf(mx, smax[w * 32 + n]);
    mx = fmaxf(mx, 1e-30f);
    __syncthreads();
    if (wave == 0 && lane < 32) SWr0[n] = mx * (1.0f / 127.0f);
    const float inv = 127.0f / mx;
#pragma unroll
    for (int u = 0; u < 4; ++u) { unsigned wd[2][4];
#pragma unroll
        for (int tt = 0; tt < 2; ++tt)
#pragma unroll
            for (int e = 0; e < 4; ++e) { const int i0 = 8 * (2 * u + tt) + 2 * e;
                const int a0 = (int)rintf(v[i0] * inv), a1 = (int)rintf(v[i0 + 1] * inv); const int b0 = __shfl_xor(a0, 32), b1 = __shfl_xor(a1, 32);
                const int ev0 = kh ? b0 : a0, od0 = kh ? a0 : b0, ev1 = kh ? b1 : a1, od1 = kh ? a1 : b1;
                wd[tt][e] = ((unsigned)ev0 & 0xffu) | (((unsigned)od0 & 0xffu) << 8) | (((unsigned)ev1 & 0xffu) << 16) | ((unsigned)od1 << 24); }
        u32x4 o; o.x = kh ? wd[1][0] : wd[0][0]; o.y = kh ? wd[1][1] : wd[0][1]; o.z = kh ? wd[1][2] : wd[0][2]; o.w = kh ? wd[1][3] : wd[0][3];
        *(u32x4*)(W8r0 + (size_t)n * 1024 + 128 * wave + 16 * (2 * u + kh)) = o; }
}
__device__ __forceinline__ void w8_strips(const Args& a, unsigned char* ws, LAS unsigned char* lds, int vcu, int G, int wave, int lane) {
    LAS float* smax = (LAS float*)(lds + 131072);
    for (int sidx = vcu; sidx < DEPTH * 256 + 2 * 176; sidx += G) {
        if (sidx < DEPTH * 256) { const int l = sidx >> 8, st = sidx & 255, r0 = st * 32, c0 = r0 < 4608 ? r0 : r0 + 512;
            w8_strip(a.in[I_WIN] + (size_t)l * 1024 * SRC_IN + c0, SRC_IN, (signed char*)(ws + WS_WIN + (size_t)l * WIN_SLOT) + (size_t)r0 * 1024, (float*)(ws + WS_WIN + (size_t)l * WIN_SLOT + WIN_SW) + r0, smax, wave, lane); }
        else { const int q = sidx - DEPTH * 256, j = q >= 176 ? 1 : 0, st = q - j * 176, r0 = st * 32, sel = (r0 >> 7) & 1, c0 = (r0 >> 8) * 128 + (r0 & 127);
            if ((DENSE_UP8_MASK >> j) & 1) w8_strip((sel ? a.in[I_W3] : a.in[I_W1]) + (size_t)j * 1024 * FF + c0, FF, (signed char*)(ws + WS_W13 + (size_t)j * W13_SLOT) + (size_t)r0 * 1024, (float*)(ws + WS_W13 + (size_t)j * W13_SLOT + W13_SW) + r0, smax, wave, lane); }
    }
}

__device__ __forceinline__ void prologue_phase(const Args& a, LAS unsigned char* lds, int vcu, int G, int tid, int wave, int lane) {
    unsigned char* ws = a.ws;
    LAS float* scr = (LAS float*)(lds + wave * 16384);
    const int gw = vcu * NWAVES + wave, NGW = G * NWAVES;
    w8_strips(a, ws, lds, vcu, G, wave, lane);
    for (int it = gw; it < 4096 + 2 * 4224; it += NGW) {
        if (it < 4096) { const int l = it >> 10, r = it & 1023;
            if (r < 512) { const int q = r & 255; const float* src = (r < 256 ? a.in[I_WBA] : a.in[I_WBF]) + (size_t)l * 512 * 1024; bf16_t* dst = (bf16_t*)(ws + WS_WB) + ((size_t)l * 3 + (r >> 8)) * 1024 * 512;
                cvt_item(src, 1024, (q >> 5) * 64, (q & 31) * 32, dst, 512, (q & 31) * 32, scr, lane); }
            else { const int q = r - 512; cvt_item(a.in[I_WOUT] + (size_t)l * 1024 * 1024, 1024, (q >> 5) * 64, (q & 31) * 32, (bf16_t*)(ws + WS_WO) + (size_t)l * 1024 * 1024, 1024, (q & 31) * 32, scr, lane); }
        } else { const int r = it - 4096, j = r >= 4224 ? 1 : 0, q = r - j * 4224; const bool f8j = ((DENSE_F8_MASK >> j) & 1) != 0;
            bf16_t* d13 = (bf16_t*)(ws + WS_W13) + (size_t)j * 2 * FF * 1024; bf16_t* d2 = (bf16_t*)(ws + WS_W2) + (size_t)j * 1024 * FF;
            if (q < 2816) { if ((DENSE_UP8_MASK >> j) & 1) continue;
                const int kb = q / 176, nb = q % 176, r0 = nb * 32, sel = (r0 >> 7) & 1, c0 = (r0 >> 8) * 128 + (r0 & 127);
                const float* src = (sel ? a.in[I_W3] : a.in[I_W1]) + (size_t)j * 1024 * FF;
                if (f8j) cvt_item8(src, FF, kb * 64, c0, (unsigned char*)d13, 1024, r0, F8_SW, scr, lane); else cvt_item(src, FF, kb * 64, c0, d13, 1024, r0, scr, lane); }
            else { const int q2 = q - 2816, kb = q2 >> 5, nb = q2 & 31; const float* src = a.in[I_W2] + (size_t)j * FF * 1024;
                if (f8j) cvt_item8(src, 1024, kb * 64, nb * 32, (unsigned char*)d2, FF, nb * 32, F8_SW, scr, lane); else cvt_item(src, 1024, kb * 64, nb * 32, d2, FF, nb * 32, scr, lane); } }
    }
    __syncthreads();
    {
        LAS float* tab = (LAS float*)lds;
        if (tid < 256) { const int j = tid & 127; const float ang = (float)j * (1.0f / 64.0f); tab[tid] = (tid < 128 ? cospif(ang) : sinpif(ang)) * 0.08838834764831845f; }
        __syncthreads();
        for (int pr_ = 0; pr_ < 1 + PROL_C; ++pr_)
        for (int it = gw; it < DEPTH * 4 * 64; it += NGW) {
            const int l = it >> 8, g = (it >> 6) & 3, kk0 = (it & 63) * 16;
            const float* p = a.in[I_WIN] + ((size_t)l * 1024 + kk0 + (lane & 15)) * SRC_IN + 4608 + g * 128 + (lane >> 4);
            float av[32];
#pragma unroll
            for (int s_ = 0; s_ < 32; ++s_) av[s_] = p[4 * s_];
            bf16_t* WINF = (bf16_t*)(ws + WS_WIN + (size_t)l * WIN_SLOT + WIN_F);
            for (int nt_ = 0; nt_ < 16; ++nt_) { const int cs = nt_ >> 3, k2 = (nt_ & 7) * 16 + (lane & 15);
                f32x4 acc = {0.f, 0.f, 0.f, 0.f}; int idx = (k2 * (lane >> 4)) & 127; const int step = (4 * k2) & 127;
#pragma unroll
                for (int s_ = 0; s_ < 32; ++s_) { const float bv = tab[cs * 128 + idx]; idx = (idx + step) & 127; acc = __builtin_amdgcn_mfma_f32_16x16x4f32(av[s_], bv, acc, 0, 0, 0); }
                u32x2 w; w.x = pk2(acc[0], acc[1]); w.y = pk2(acc[2], acc[3]);
                *(u32x2*)(WINF + (size_t)(cs * 512 + g * 128 + k2) * 1024 + kk0 + 4 * (lane >> 4)) = w; }
        }
        __syncthreads();
    }
    for (int it = vcu; it < DEPTH * 4 * 16; it += G) {
        const int l = it >> 6, g = (it >> 4) & 3, db = it & 15;
        const int d = db * 64 + lane;
        float reg[128];
        const float* wbp = a.in[I_WBP] + ((size_t)l * 512 + g * 128) * 1024 + d;
        const float* ps = a.in[I_POOLS] + l * 512 + g * 128;
#pragma unroll
        for (int j = 0; j < 128; ++j) reg[j] = wbp[(size_t)j * 1024] * ps[j];
        const float* pw = a.in[I_POOLW] + ((size_t)(l * 4 + g) * 128) * 128;
        bf16_t* WB2 = (bf16_t*)(ws + WS_WB) + ((size_t)l * 3 + 2) * 1024 * 512;
        for (int o = 0; o < 16; ++o) { const int c = wave * 16 + o; const float* pr = pw + c * 128; float s = 0.f;
#pragma unroll
            for (int j = 0; j < 128; ++j) { s += pr[j] * reg[j]; if ((j & 15) == 15) __builtin_amdgcn_sched_barrier(0); }
            WB2[(size_t)d * 512 + g * 128 + c] = (bf16_t)(pk2(s, 0.f) & 0xffffu); }
    }
    {
        __syncthreads();
        LAS float* ctab = (LAS float*)lds;
        for (int j = tid; j < 4096; j += NTHR) ctab[j] = cospif((float)j * (1.0f / 2048.0f)) * 0.015625f;
        __syncthreads();
        unsigned char* DS = (unsigned char*)(ws + WS_DS);
        const int nthr = G * NTHR;
        for (int id = vcu * NTHR + tid; id < 2048 * 512; id += nthr) {
            const int k1 = id >> 9, col = (id & 511) * 8, cs = col >> 11, pos = col & 2047;
            float v[8];
#pragma unroll
            for (int j = 0; j < 8; ++j) v[j] = ctab[(k1 * (pos + j) + (cs ? 1024 : 0)) & 4095] * DFT_SA;
            u32x2 w; w.x = pk8x4(v[0], v[1], v[2], v[3]); w.y = pk8x4(v[4], v[5], v[6], v[7]);
            *(u32x2*)(DS + (size_t)k1 * 4096 + col) = w;
        }
    }
}

__device__ __forceinline__ unsigned q8x4(f32x4 y, float inv) { const int a = (int)rintf(y.x * inv), b = (int)rintf(y.y * inv), c = (int)rintf(y.z * inv), d = (int)rintf(y.w * inv);
    return ((unsigned)a & 0xffu) | (((unsigned)b & 0xffu) << 8) | (((unsigned)c & 0xffu) << 16) | ((unsigned)d << 24); }
__device__ __forceinline__ float wave_max(float v) {
#pragma unroll
    for (int o = 1; o < 64; o <<= 1) v = fmaxf(v, __shfl_xor(v, o));
    return v;
}
template <int QM>
__device__ __forceinline__ void norm_phase(const bf16_t* xsrc, const float* gain, void* h, float* sh, int vcu, int G, int wave, int lane) {
    constexpr bool F8 = QM == 1;
    const int gw = vcu * NWAVES + wave, NGW = G * NWAVES;
    f32x4 gv[4];
#pragma unroll
    for (int j = 0; j < 4; ++j) gv[j] = ((const f32x4*)gain)[lane + 64 * j];
    for (int m = gw; m < NTOK; m += NGW) {
        f32x4 v[4]; float s = 0.f;
#pragma unroll
        for (int j = 0; j < 4; ++j) v[j] = ldx4<true>(xsrc + (size_t)m * DM, lane + 64 * j);
#pragma unroll
        for (int j = 0; j < 4; ++j) s += (v[j].x * v[j].x + v[j].y * v[j].y) + (v[j].z * v[j].z + v[j].w * v[j].w);
        const float rstd = 1.0f / sqrtf(wave_sum(s) * (1.f / DM) + RMS_EPS);
        u32x2* o8 = (u32x2*)((bf16_t*)h + (size_t)m * DM) + lane; unsigned* o4 = (unsigned*)((unsigned char*)h + (size_t)m * DM) + lane;
        if constexpr (QM == 2) { float mx = 0.f;
#pragma unroll
            for (int j = 0; j < 4; ++j) { v[j] = v[j] * rstd * gv[j];
#pragma unroll
                for (int e = 0; e < 4; ++e) mx = fmaxf(mx, fabsf(v[j][e])); }
            mx = fmaxf(wave_max(mx), 1e-30f); const float inv = 127.0f / mx;
            if (lane == 0) sh[m] = mx * (1.0f / 127.0f);
#pragma unroll
            for (int j = 0; j < 4; ++j) o4[64 * j] = q8x4(v[j], inv);
        } else {
#pragma unroll
        for (int j = 0; j < 4; ++j) { const f32x4 y = v[j] * rstd * gv[j];
            if constexpr (F8) o4[64 * j] = pk8x4(y.x, y.y, y.z, y.w); else { u32x2 w; w.x = pk2(y.x, y.y); w.y = pk2(y.z, y.w); o8[64 * j] = w; } } }
    }
}
template <bool BF>
__device__ __forceinline__ void norm1_pair_phase(const void* xsrc_, const bf16_t* yadd, bf16_t* xdst, const float* gain, signed char* h8, float* sh, bf16_t* hf, int vcu, int G, int wave, int lane) {
    const char* xsrc = (const char*)xsrc_; constexpr size_t RB = (size_t)DM * (BF ? 2 : 4);
    const int gw = vcu * NWAVES + wave, NGW = G * NWAVES;
    f32x4 gv[4];
#pragma unroll
    for (int j = 0; j < 4; ++j) gv[j] = ((const f32x4*)gain)[lane + 64 * j];
    for (int idx = gw; idx < NBATCH * 2049; idx += NGW) {
        const int b = idx / 2049, j = idx - b * 2049; const bool pair = j >= 1 && j <= 2047;
        const int mA = b * SEQ + j, mB = b * SEQ + (pair ? SEQ - j : j);
        f32x4 va[4], vb[4];
#pragma unroll
        for (int q = 0; q < 4; ++q) { va[q] = ldx4<BF>(xsrc + (size_t)mA * RB, lane + 64 * q); vb[q] = ldx4<BF>(xsrc + (size_t)mB * RB, lane + 64 * q); }
        if (yadd) {
#pragma unroll
            for (int q = 0; q < 4; ++q) { va[q] += ldx4<true>(yadd + (size_t)mA * DM, lane + 64 * q); vb[q] += ldx4<true>(yadd + (size_t)mB * DM, lane + 64 * q); } }
        if (xdst) {
#pragma unroll
            for (int q = 0; q < 4; ++q) { stx4(xdst + (size_t)mA * DM, lane + 64 * q, va[q]); if (pair) stx4(xdst + (size_t)mB * DM, lane + 64 * q, vb[q]); } }
        float sa = 0.f, sb = 0.f;
#pragma unroll
        for (int q = 0; q < 4; ++q) { sa += (va[q].x * va[q].x + va[q].y * va[q].y) + (va[q].z * va[q].z + va[q].w * va[q].w); sb += (vb[q].x * vb[q].x + vb[q].y * vb[q].y) + (vb[q].z * vb[q].z + vb[q].w * vb[q].w); }
        const float ra = 1.0f / sqrtf(wave_sum(sa) * (1.f / DM) + RMS_EPS), rb = 1.0f / sqrtf(wave_sum(sb) * (1.f / DM) + RMS_EPS);
        float ma = 0.f, mb = 0.f;
#pragma unroll
        for (int q = 0; q < 4; ++q) { va[q] = va[q] * ra * gv[q]; vb[q] = vb[q] * rb * gv[q];
#pragma unroll
            for (int e = 0; e < 4; ++e) { ma = fmaxf(ma, fabsf(va[q][e])); mb = fmaxf(mb, fabsf(vb[q][e])); } }
        ma = fmaxf(wave_max(ma), 1e-30f); mb = fmaxf(wave_max(mb), 1e-30f);
        const float ia = 127.0f / ma, ib = 127.0f / mb;
        unsigned* oa = (unsigned*)(h8 + (size_t)mA * DM) + lane; unsigned* ob = (unsigned*)(h8 + (size_t)mB * DM) + lane;
        u32x2* os = (u32x2*)(hf + ((size_t)(b * 2 + 0) * 2048 + j) * DM) + lane; u32x2* od = (u32x2*)(hf + ((size_t)(b * 2 + 1) * 2048 + j) * DM) + lane;
        if (lane == 0) { sh[mA] = ma * (1.0f / 127.0f); if (pair) sh[mB] = mb * (1.0f / 127.0f); }
#pragma unroll
        for (int q = 0; q < 4; ++q) { const f32x4 ya = va[q], yb = vb[q];
            oa[64 * q] = q8x4(ya, ia);
            if (pair) { ob[64 * q] = q8x4(yb, ib);
                const f32x4 ys = ya + yb, yd = ya - yb; u32x2 w; w.x = pk2(ys.x, ys.y); w.y = pk2(ys.z, ys.w); os[64 * q] = w; w.x = pk2(yd.x, yd.y); w.y = pk2(yd.z, yd.w); od[64 * q] = w; }
            else if (j == 0) { u32x2 w; w.x = pk2(ya.x, ya.y); w.y = pk2(ya.z, ya.w); os[64 * q] = w; od[64 * q] = (u32x2){0u, 0u}; } }
    }
}
__device__ __forceinline__ void t2048_phase(const signed char* h8, const float* sh, const bf16_t* wcos, float* T, int vcu, int G, int wave, int lane) {
    const int gw = vcu * NWAVES + wave, NGW = G * NWAVES;
    for (int idx = gw; idx < NBATCH * 512; idx += NGW) { const int b = idx >> 9, c = idx & 511; const size_t row = (size_t)b * SEQ + 2048;
        const u32x4 a = ((const u32x4*)(h8 + row * DM))[lane];
        const u32x4* wp = (const u32x4*)(wcos + (size_t)c * DM) + 2 * lane; const u32x4 w0 = wp[0], w1 = wp[1];
        const unsigned aw[4] = {a.x, a.y, a.z, a.w}; const unsigned ww[8] = {w0.x, w0.y, w0.z, w0.w, w1.x, w1.y, w1.z, w1.w};
        float s = 0.f;
#pragma unroll
        for (int e = 0; e < 4; ++e) { const int q0 = (int)(aw[e] << 24) >> 24, q1 = (int)(aw[e] << 16) >> 24, q2 = (int)(aw[e] << 8) >> 24, q3 = (int)aw[e] >> 24;
            s += (float)q0 * bf_lo(ww[2 * e]) + (float)q1 * bf_hi(ww[2 * e]) + (float)q2 * bf_lo(ww[2 * e + 1]) + (float)q3 * bf_hi(ww[2 * e + 1]); }
        s = wave_sum(s) * sh[row];
        if (lane == 0) T[idx] = s; }
}
__device__ __forceinline__ void add_phase(float* out, const bf16_t* x, const bf16_t* y, int vcu, int G, int tid) {
    const int nthr = G * NTHR;
    for (int id = vcu * NTHR + tid; id < NTOK * DM / 8; id += nthr) { const u32x4 a = ((const u32x4*)x)[id], b = ((const u32x4*)y)[id];
        ((f32x4*)out)[2 * id] = (f32x4){bf_lo(a.x) + bf_lo(b.x), bf_hi(a.x) + bf_hi(b.x), bf_lo(a.y) + bf_lo(b.y), bf_hi(a.y) + bf_hi(b.y)};
        ((f32x4*)out)[2 * id + 1] = (f32x4){bf_lo(a.z) + bf_lo(b.z), bf_hi(a.z) + bf_hi(b.z), bf_lo(a.w) + bf_lo(b.w), bf_hi(a.w) + bf_hi(b.w)}; }
}
template <bool F8>
__device__ __forceinline__ void norm_router_phase(const bf16_t* x, const float* gain, const float* rw, const float* rb, void* h, unsigned* gcnt, u32x2* rinfo, unsigned long long* gran, const unsigned epoch,
                                                  LAS unsigned char* lds, int vcu, int G, int tid, int wave, int lane) {
    LAS unsigned* lcnt = (LAS unsigned*)(lds + MISC_OFF + 64);
    LAS unsigned* lbase = lcnt + 8;
    LAS unsigned* sel = lcnt + 16;
    LAS unsigned* wcnt = (LAS unsigned*)(lds + MISC_OFF + 3456);
    f32x4 gv[4];
#pragma unroll
    for (int j = 0; j < 4; ++j) gv[j] = ((const f32x4*)gain)[lane + 64 * j];
    float rwv[16][8];
#pragma unroll
    for (int j = 0; j < 4; ++j)
#pragma unroll
        for (int q = 0; q < 4; ++q) { const int d = 4 * lane + 256 * j + q; const f32x4 a0 = *(const f32x4*)(rw + d * 8), a1 = *(const f32x4*)(rw + d * 8 + 4);
            rwv[j * 4 + q][0] = a0[0]; rwv[j * 4 + q][1] = a0[1]; rwv[j * 4 + q][2] = a0[2]; rwv[j * 4 + q][3] = a0[3]; rwv[j * 4 + q][4] = a1[0]; rwv[j * 4 + q][5] = a1[1]; rwv[j * 4 + q][6] = a1[2]; rwv[j * 4 + q][7] = a1[3]; }
    float rbv[8];
#pragma unroll
    for (int e = 0; e < 8; ++e) rbv[e] = rb[e];
    for (int ck = vcu; ck < NTOK / 128; ck += G) {
        if (tid < 8) lcnt[tid] = 0u;
        __syncthreads();
        for (int rr = 0; rr < 16; ++rr) {
            const int rl = wave * 16 + rr, m = ck * 128 + rl;
            f32x4 v[4]; float s = 0.f;
#pragma unroll
            for (int j = 0; j < 4; ++j) { v[j] = ldx4<true>(x + (size_t)m * DM, lane + 64 * j); s += (v[j].x * v[j].x + v[j].y * v[j].y) + (v[j].z * v[j].z + v[j].w * v[j].w); }
            const float rstd = 1.0f / sqrtf(wave_sum(s) * (1.f / DM) + RMS_EPS);
            u32x2* o8 = (u32x2*)((bf16_t*)h + (size_t)m * DM) + lane; unsigned* o4 = (unsigned*)((unsigned char*)h + (size_t)m * DM) + lane;
            float lg[8];
#pragma unroll
            for (int e = 0; e < 8; ++e) lg[e] = 0.f;
#pragma unroll
            for (int j = 0; j < 4; ++j) { const f32x4 y = v[j] * rstd * gv[j];
                if constexpr (F8) o4[64 * j] = pk8x4(y.x, y.y, y.z, y.w); else { u32x2 w; w.x = pk2(y.x, y.y); w.y = pk2(y.z, y.w); o8[64 * j] = w; }
#pragma unroll
                for (int e = 0; e < 8; ++e) lg[e] += y.x * rwv[j * 4 + 0][e] + y.y * rwv[j * 4 + 1][e] + y.z * rwv[j * 4 + 2][e] + y.w * rwv[j * 4 + 3][e]; }
#pragma unroll
            for (int e = 0; e < 8; ++e) lg[e] = wave_sum(lg[e]) + rbv[e];
            int e0 = 0; float v0 = lg[0];
#pragma unroll
            for (int e = 1; e < 8; ++e) if (lg[e] > v0) { v0 = lg[e]; e0 = e; }
            int e1 = -1; float v1 = -3.0e38f;
#pragma unroll
            for (int e = 0; e < 8; ++e) if (e != e0 && lg[e] > v1) { v1 = lg[e]; e1 = e; }
            const float g0 = 1.0f / (1.0f + __expf(v1 - v0)), g1 = 1.0f - g0;
            if (lane == 0) {
                sel[(rl * 2 + 0) * 3 + 0] = (unsigned)e0; sel[(rl * 2 + 0) * 3 + 2] = __float_as_uint(g0);
                sel[(rl * 2 + 1) * 3 + 0] = (unsigned)e1; sel[(rl * 2 + 1) * 3 + 2] = __float_as_uint(g1);
            }
        }
        __syncthreads();
        unsigned my_e = 0u, my_rank = 0u;
        if (tid < 256) { my_e = sel[tid * 3 + 0];
#pragma unroll
            for (int ee = 0; ee < 8; ++ee) { const unsigned long long mk = __ballot(my_e == (unsigned)ee);
                if (my_e == (unsigned)ee) my_rank = (unsigned)__popcll(mk & ((1ull << lane) - 1ull));
                if (lane == ee) wcnt[wave * 8 + ee] = (unsigned)__popcll(mk); } }
        __syncthreads();
        if (tid < 8) { const unsigned c = wcnt[tid] + wcnt[8 + tid] + wcnt[16 + tid] + wcnt[24 + tid]; lcnt[tid] = c; lbase[tid] = 0u;
            __hip_atomic_store(gran + (size_t)ck * 8 + tid, ((unsigned long long)epoch << 32) | c, __ATOMIC_RELAXED, __HIP_MEMORY_SCOPE_AGENT); }
        __syncthreads();
        { unsigned part = 0u;
          for (int idx = tid; idx < ck * 8; idx += NTHR) { unsigned long long g = 0ull; unsigned sp = 0u;
              do { g = __hip_atomic_load(gran + idx, __ATOMIC_RELAXED, __HIP_MEMORY_SCOPE_AGENT); if ((unsigned)(g >> 32) == epoch) break; __builtin_amdgcn_s_sleep(1); } while (++sp < (1u << 20));
              part += (unsigned)g; }
          if (part) __hip_atomic_fetch_add(lbase + (tid & 7), part, __ATOMIC_RELAXED, __HIP_MEMORY_SCOPE_WORKGROUP); }
        __syncthreads();
        if (tid < 256) { const int rl = tid >> 1, k = tid & 1; const unsigned gb = sel[tid * 3 + 2]; unsigned rk = my_rank;
            for (int w2 = 0; w2 < wave; ++w2) rk += wcnt[w2 * 8 + my_e];
            u32x2 ri; ri.x = (unsigned)(ck * 128 + rl) | ((unsigned)k << 31); ri.y = gb; rinfo[(size_t)my_e * 32768 + lbase[my_e] + rk] = ri; }
        if (ck == NTOK / 128 - 1 && tid < 8) __hip_atomic_store(gcnt + tid, lbase[tid] + lcnt[tid], __ATOMIC_RELAXED, __HIP_MEMORY_SCOPE_AGENT);
        __syncthreads();
    }
}

__device__ __forceinline__ int kv_off(int row, int ch) { return 256 * row + 16 * (ch ^ (((row & 3) << 2) | ((row >> 2) & 3))); }
__device__ __forceinline__ int t5_bucket(int rel) {
    const int n = rel < 0 ? -rel : rel; const int ret = rel > 0 ? 16 : 0;
    const int v = n < 8 ? n : 8 + (n >= 15) + (n >= 27) + (n >= 50) + (n >= 91) + (n >= 166) + (n >= 305) + (n >= 559);
    return ret + v;
}
template <int OFF> __device__ __forceinline__ long tr8_read_off(unsigned addr) { long r; asm volatile("ds_read_b64_tr_b8 %0, %1 offset:%2" : "=v"(r) : "v"(addr), "i"(OFF) : "memory"); return r; }
__device__ __forceinline__ void attn_unit_rows(int u, int wave, int lane, unsigned (&koffs)[4]) {
    const int b = u / 384, rem = u % 384, h = rem >> 5, c = rem & 31, sh = 2 * (h >> 2), L = SEQ >> sh, cpr = 32 >> sh, r = c / cpr, jp = c % cpr;
#pragma unroll
    for (int i = 0; i < 4; ++i) { const int row = 8 * (wave * 4 + i) + (lane >> 3); const int ks = 128 * jp - 64 + row; const bool ok = ks >= 0 && ks < L;
        koffs[i] = (unsigned)(b * SEQ + ((ok ? ks : 0) << sh) + r) * 4608u + (unsigned)(1536 + h * 128); }
}
__device__ __forceinline__ void attn_phase(LAS unsigned char* lds, const bf16_t* qkv, const float* relb, bf16_t* og, float* lse,
                                           int vcu, int G, int tid, int wave, int lane) {
    LAS float* bt = (LAS float*)(lds + BT_OFF);
    for (int i = tid; i < 12 * 129; i += NTHR) { const int h = i / 129, o = i % 129 - 64; const int g = h >> 2; bt[h * 160 + o + 80] = relb[t5_bucket(o * (1 << (2 * g))) * 12 + h] * 1.4426950408889634f; }
    for (int i = tid; i < 128; i += NTHR) *(LAS u32x4*)(lds + AT_V + 256 * 128 + i * 16) = (u32x4){0u, 0u, 0u, 0u};
    const int qi = lane & 15, fq = lane >> 4;
    unsigned kbase[4], vbase[8];
    {
#pragma unroll
      for (int ks = 0; ks < 4; ++ks) kbase[ks] = (unsigned)(AT_K + 2048 * wave + 128 * qi + 16 * ((2 * ks + (fq >> 1)) ^ (qi & 7)) + 8 * (fq & 1));
      const int rp = (lane & 15) >> 1, cp = lane & 1, rowl = 16 * wave + 4 * fq + (rp & 3) + ((rp >> 2) ? 16 : 0), xv = 4 * (fq & 1) + (rp & 3);
#pragma unroll
      for (int dt = 0; dt < 8; ++dt) vbase[dt] = (unsigned)(AT_V + 128 * rowl + 16 * (dt ^ xv) + 8 * cp); }
    const char* qk8 = (const char*)qkv;
#define AT_ISSUE_V(koffs) do { const int ch_ = (lane & 7) ^ (lane >> 3); _Pragma("unroll") for (int i_ = 0; i_ < 4; ++i_) \
        __builtin_amdgcn_global_load_lds((const unsigned*)(qk8 + (koffs)[i_] + 1536 + ch_ * 16), (LAS unsigned*)(lds + AT_V + (wave * 4 + i_) * 1024), 16, 0, 0); } while (0)
#define AT_ISSUE_K(koffs) do { const int ch_ = (lane & 7) ^ (lane >> 3); _Pragma("unroll") for (int i_ = 0; i_ < 4; ++i_) \
        __builtin_amdgcn_global_load_lds((const unsigned*)(qk8 + (koffs)[i_] + ch_ * 16), (LAS unsigned*)(lds + AT_K + (wave * 4 + i_) * 1024), 16, 0, 0); } while (0)
#define AT_LOADQ(u_) do { const int b_ = (u_) / 384, rem_ = (u_) % 384, h_ = rem_ >> 5, c_ = rem_ & 31, sh_ = 2 * (h_ >> 2), cpr_ = 32 >> sh_, r_ = c_ / cpr_, jp_ = c_ % cpr_; \
        const char* p_q = qk8 + ((size_t)b_ * SEQ + (size_t)((128 * jp_ + 16 * wave + qi) << sh_) + r_) * 4608 + h_ * 128 + fq * 8; \
        _Pragma("unroll") for (int ks = 0; ks < 4; ++ks) Qf[ks] = *(const long*)(p_q + 32 * ks); } while (0)
    __syncthreads();
    unsigned koffs[4]; long Qf[4];
    int u = vcu;
    if (u < NBATCH * 12 * 32) { attn_unit_rows(u, wave, lane, koffs); AT_ISSUE_K(koffs); AT_LOADQ(u); AT_ISSUE_V(koffs); }
    for (; u < NBATCH * 12 * 32; u += G) {
        const int b = u / 384, rem = u % 384, h = rem >> 5, c = rem & 31, g = h >> 2, sh = 2 * g, L = SEQ >> sh, cpr = 32 >> sh;
        const int r = c / cpr, jp = c % cpr;
        const size_t tokq = (size_t)b * SEQ + (size_t)((128 * jp + 16 * wave + qi) << sh) + r;
        const bool has_next = (u + G) < NBATCH * 12 * 32;
        asm volatile("s_waitcnt vmcnt(4)" ::: "memory"); __builtin_amdgcn_s_barrier(); asm volatile("" ::: "memory");
        f32x4 S[10];
#pragma unroll
        for (int t = 0; t < 9; ++t) { f32x4 acc = {0.f, 0.f, 0.f, 0.f};
#pragma unroll
            for (int ks = 0; ks < 4; ++ks) { const long kf = *(const LAS long*)(lds + kbase[ks] + 2048 * t); acc = __builtin_amdgcn_mfma_f32_16x16x32_fp8_fp8(kf, Qf[ks], acc, 0, 0, 0); }
            S[t] = acc; }
        S[9] = (f32x4){0.f, 0.f, 0.f, 0.f};
        const LAS float* btl = bt + h * 160 + 16 + 4 * fq - qi;
        const int d0 = 4 * fq - qi - 64, kb0 = 128 * jp - 64 + 16 * wave + 4 * fq;
        const int lob = (-64 - d0) > (-kb0) ? (-64 - d0) : (-kb0), hib = (64 - d0) < (L - 1 - kb0) ? (64 - d0) : (L - 1 - kb0);
        float mx = -3.0e38f;
#pragma unroll
        for (int t = 0; t < 9; ++t)
#pragma unroll
            for (int j = 0; j < 4; ++j) { const int e = 16 * t + j; const bool ok = e >= lob && e <= hib;
                const float sv = ok ? S[t][j] * (1.4426950408889634f / 512.0f) + btl[e] : -1.0e30f; S[t][j] = sv; mx = fmaxf(mx, sv); }
        mx = fmaxf(mx, __shfl_xor(mx, 16)); mx = fmaxf(mx, __shfl_xor(mx, 32));
        float den = 0.f; const float mx8 = mx - 8.0f;
#pragma unroll
        for (int t = 0; t < 9; ++t)
#pragma unroll
            for (int j = 0; j < 4; ++j) { const float p = __builtin_amdgcn_exp2f(S[t][j] - mx8); S[t][j] = p; den += p; }
        den += __shfl_xor(den, 16); den += __shfl_xor(den, 32); den *= (1.0f / 256.0f);
        asm volatile("s_waitcnt vmcnt(0)" ::: "memory"); __builtin_amdgcn_s_barrier(); asm volatile("" ::: "memory");
        if (has_next) { attn_unit_rows(u + G, wave, lane, koffs); AT_ISSUE_K(koffs); AT_LOADQ(u + G); }
        f32x4 O[8];
#pragma unroll
        for (int dt = 0; dt < 8; ++dt) O[dt] = (f32x4){0.f, 0.f, 0.f, 0.f};
#define PV_STEP(T) { long pf; { u32x2 pw; pw.x = pk8x4_nc(S[2 * (T)][0], S[2 * (T)][1], S[2 * (T)][2], S[2 * (T)][3]); \
                pw.y = pk8x4_nc(S[2 * (T) + 1][0], S[2 * (T) + 1][1], S[2 * (T) + 1][2], S[2 * (T) + 1][3]); pf = __builtin_bit_cast(long, pw); } \
            long vf[8]; \
            _Pragma("unroll") for (int dt = 0; dt < 8; ++dt) vf[dt] = tr8_read_off<4096 * (T)>(vbase[dt]); \
            asm volatile("s_waitcnt lgkmcnt(0)" : "+v"(vf[0]), "+v"(vf[1]), "+v"(vf[2]), "+v"(vf[3]), "+v"(vf[4]), "+v"(vf[5]), "+v"(vf[6]), "+v"(vf[7]) :: "memory"); \
            _Pragma("unroll") for (int dt = 0; dt < 8; ++dt) O[dt] = __builtin_amdgcn_mfma_f32_16x16x32_fp8_fp8(vf[dt], pf, O[dt], 0, 0, 0); }
        PV_STEP(0) PV_STEP(1) PV_STEP(2) PV_STEP(3) PV_STEP(4)
#undef PV_STEP
        const float rden = 1.0f / den;
        unsigned char* op = (unsigned char*)og + ((size_t)g * NTOK + tokq) * 512 + (h & 3) * 128 + 4 * fq;
        const float rd16 = rden * (16.0f / 2048.0f);
#pragma unroll
        for (int dt = 0; dt < 8; ++dt) *(unsigned*)(op + 16 * dt) = pk8x4(O[dt][0] * rd16, O[dt][1] * rd16, O[dt][2] * rd16, O[dt][3] * rd16);
        if (fq == 0) lse[((size_t)g * NTOK + tokq) * 4 + (h & 3)] = (mx + __builtin_amdgcn_logf(den)) * 0.6931471805599453f;
        asm volatile("s_waitcnt lgkmcnt(0)" ::: "memory"); __builtin_amdgcn_s_barrier(); asm volatile("" ::: "memory");
        if (has_next) AT_ISSUE_V(koffs);
    }
    asm volatile("s_waitcnt vmcnt(0)" ::: "memory"); __syncthreads();
#undef AT_ISSUE_K
#undef AT_ISSUE_V
#undef AT_LOADQ
}

template <int HW>
__device__ __forceinline__ void pool_item(const bf16_t* UP, bf16_t* PD, int t, int ch) {
    const int pos = t & 4095;
    const bf16_t* base = UP + (size_t)(t - pos) * 512 + ch * 8;
    u32x4 v[2 * HW];
#pragma unroll
    for (int k = 0; k < 2 * HW; ++k) { const int p = pos - HW + k; const int pc = p < 0 ? 0 : (p > 4095 ? 4095 : p); v[k] = *(const u32x4*)(base + (size_t)pc * 512); }
    float s[8];
#pragma unroll
    for (int e = 0; e < 8; ++e) s[e] = 0.f;
    int cnt = 0;
#pragma unroll
    for (int k = 0; k < 2 * HW; ++k) { const int p = pos - HW + k; const bool ok = p >= 0 && p <= 4095; const float m = ok ? 1.0f : 0.0f; cnt += ok ? 1 : 0;
        s[0] += m * bf_lo(v[k].x); s[1] += m * bf_hi(v[k].x); s[2] += m * bf_lo(v[k].y); s[3] += m * bf_hi(v[k].y); s[4] += m * bf_lo(v[k].z); s[5] += m * bf_hi(v[k].z); s[6] += m * bf_lo(v[k].w); s[7] += m * bf_hi(v[k].w); }
    const u32x4 me = v[HW];
    const float rc = 1.0f / (float)cnt;
    u32x4 w; w.x = pk2(s[0] * rc - bf_lo(me.x), s[1] * rc - bf_hi(me.x)); w.y = pk2(s[2] * rc - bf_lo(me.y), s[3] * rc - bf_hi(me.y));
    w.z = pk2(s[4] * rc - bf_lo(me.z), s[5] * rc - bf_hi(me.z)); w.w = pk2(s[6] * rc - bf_lo(me.w), s[7] * rc - bf_hi(me.w));
    *(u32x4*)(PD + (size_t)t * 512 + ch * 8) = w;
}
__device__ __forceinline__ void pool_phase(const bf16_t* UP, bf16_t* PD, int vcu, int G, int wave, int lane) {
    const int gw = vcu * NWAVES + wave, NGW = G * NWAVES;
    for (int it = gw; it < (NTOK / 4) * 4; it += NGW) {
        const int g = it & 3, t = (it >> 2) * 4 + (lane >> 4), ch = g * 16 + (lane & 15);
        if (g == 0) pool_item<1>(UP, PD, t, ch); else if (g == 1) pool_item<2>(UP, PD, t, ch); else if (g == 2) pool_item<4>(UP, PD, t, ch); else pool_item<8>(UP, PD, t, ch);
    }
}
__device__ __forceinline__ void combine_phase(const bf16_t* og, const float* lse, bf16_t* ATTN, int vcu, int G, int tid) {
    const int nthr = G * NTHR;
    int z; asm volatile("v_mov_b32 %0, 0" : "=v"(z));
    for (int id = vcu * NTHR + tid + z; id < NTOK * 64; id += nthr) {
        const int t = id >> 6, ch = id & 63, hs = ch >> 4;
        const float l0 = lse[((size_t)0 * NTOK + t) * 4 + hs], l1 = lse[((size_t)1 * NTOK + t) * 4 + hs], l2 = lse[((size_t)2 * NTOK + t) * 4 + hs];
        const float m = fmaxf(l0, fmaxf(l1, l2)); float w0 = __expf(l0 - m), w1 = __expf(l1 - m), w2 = __expf(l2 - m); const float rs = 1.0f / (w0 + w1 + w2); w0 *= rs; w1 *= rs; w2 *= rs;
        const unsigned char* o8 = (const unsigned char*)og + (size_t)t * 512 + ch * 8;
        const u32x2 a = *(const u32x2*)o8, bq = *(const u32x2*)(o8 + (size_t)NTOK * 512), cq = *(const u32x2*)(o8 + (size_t)2 * NTOK * 512);
        w0 *= 0.0625f; w1 *= 0.0625f; w2 *= 0.0625f;
        const f32x2 a0 = __builtin_amdgcn_cvt_pk_f32_fp8((int)a.x, false), a1 = __builtin_amdgcn_cvt_pk_f32_fp8((int)a.x, true), a2 = __builtin_amdgcn_cvt_pk_f32_fp8((int)a.y, false), a3 = __builtin_amdgcn_cvt_pk_f32_fp8((int)a.y, true);
        const f32x2 b0 = __builtin_amdgcn_cvt_pk_f32_fp8((int)bq.x, false), b1 = __builtin_amdgcn_cvt_pk_f32_fp8((int)bq.x, true), b2 = __builtin_amdgcn_cvt_pk_f32_fp8((int)bq.y, false), b3 = __builtin_amdgcn_cvt_pk_f32_fp8((int)bq.y, true);
        const f32x2 c0 = __builtin_amdgcn_cvt_pk_f32_fp8((int)cq.x, false), c1 = __builtin_amdgcn_cvt_pk_f32_fp8((int)cq.x, true), c2 = __builtin_amdgcn_cvt_pk_f32_fp8((int)cq.y, false), c3 = __builtin_amdgcn_cvt_pk_f32_fp8((int)cq.y, true);
        const f32x2 r0 = a0 * w0 + b0 * w1 + c0 * w2, r1 = a1 * w0 + b1 * w1 + c1 * w2, r2 = a2 * w0 + b2 * w1 + c2 * w2, r3 = a3 * w0 + b3 * w1 + c3 * w2;
        u32x4 w; w.x = pk2(r0.x, r0.y); w.y = pk2(r1.x, r1.y); w.z = pk2(r2.x, r2.y); w.w = pk2(r3.x, r3.y);
        *(u32x4*)(ATTN + (size_t)t * 512 + ch * 8) = w;
    }
}

__device__ __forceinline__ void dft_combine_phase(const bf16_t* P, const float* T, const unsigned char* Ytf, bf16_t* FOUR, int vcu, int G, int tid, int wave, int lane) {
    const int nthr = G * NTHR;
    int z; asm volatile("v_mov_b32 %0, 0" : "=v"(z));
    for (int id = vcu * NTHR + tid + z; id < NBATCH * 2048 * 64; id += nthr) {
        const int ch = id & 63, k1 = (id >> 6) & 2047, b = id >> 17;
        const bf16_t* p1 = P + ((size_t)(b * 2048 + k1)) * 512 + ch * 8; const bf16_t* p2 = p1 + (size_t)8 * 2048 * 512;
        const u32x4 pa = *(const u32x4*)p1, pb = *(const u32x4*)p2;
        const f32x4 a0 = {bf_lo(pa.x), bf_hi(pa.x), bf_lo(pa.y), bf_hi(pa.y)}, a1 = {bf_lo(pa.z), bf_hi(pa.z), bf_lo(pa.w), bf_hi(pa.w)}, b0 = {bf_lo(pb.x), bf_hi(pb.x), bf_lo(pb.y), bf_hi(pb.y)}, b1 = {bf_lo(pb.z), bf_hi(pb.z), bf_lo(pb.w), bf_hi(pb.w)};
        const float sg = (k1 & 1) ? -0.015625f : 0.015625f;
        const f32x4 t0 = *(const f32x4*)(T + b * 512 + ch * 8) * sg, t1 = *(const f32x4*)(T + b * 512 + ch * 8 + 4) * sg;
        { const f32x4 v0 = a0 + b0 + t0, v1 = a1 + b1 + t1; u32x4 w; w.x = pk2(v0[0], v0[1]); w.y = pk2(v0[2], v0[3]); w.z = pk2(v1[0], v1[1]); w.w = pk2(v1[2], v1[3]);
          *(u32x4*)(FOUR + ((size_t)b * SEQ + k1) * 512 + ch * 8) = w; }
        if (k1 > 0) { const f32x4 v0 = a0 - b0 + t0, v1 = a1 - b1 + t1; u32x4 w; w.x = pk2(v0[0], v0[1]); w.y = pk2(v0[2], v0[3]); w.z = pk2(v1[0], v1[1]); w.w = pk2(v1[2], v1[3]);
          *(u32x4*)(FOUR + ((size_t)b * SEQ + SEQ - k1) * 512 + ch * 8) = w; }
    }
    const int gw = vcu * NWAVES + wave, NGW = G * NWAVES;
    for (int idx = gw; idx < NBATCH * 512; idx += NGW) {
        const u32x4* yp = (const u32x4*)(Ytf + (size_t)idx * 4096) + lane; float s = 0.f;
#pragma unroll
        for (int q = 0; q < 2; ++q) { const u32x4 y = yp[64 * q]; const unsigned yw[4] = {y.x, y.y, y.z, y.w};
#pragma unroll
            for (int e = 0; e < 4; ++e) { const f32x2 lo = __builtin_amdgcn_cvt_pk_f32_fp8((int)yw[e], false), hi = __builtin_amdgcn_cvt_pk_f32_fp8((int)yw[e], true); s += (lo[0] - lo[1]) + (hi[0] - hi[1]); } }
        s = wave_sum(s) * (1.0f / DFT_SY);
        if (lane == 0) { const float v = (s + T[idx]) * 0.015625f; FOUR[((size_t)(idx >> 9) * SEQ + 2048) * 512 + (idx & 511)] = (bf16_t)(pk2(v, 0.f) & 0xffffu); }
    }
}

constexpr int NSTEPS = 42;
#if ONE_LAUNCH
#define GRID_BAR() xcd_barrier(bar)
#else
#define GRID_BAR() do {} while (0)
#endif
#ifndef PHMASK
#define PHMASK 0xFFFFFFFFu
#endif
#ifndef SUBREP_A
#define SUBREP_A 0
#define SUBREP_B 0
#define SUBREP_C 0
#endif
#ifndef REPMASK
#define REPMASK 0u
#endif
#define REPS(k) (1 + (int)((REPMASK >> (k)) & 1u))
#define IN(k) (lo <= (k) && (k) < hi)
#ifndef BAR_REPS
#define BAR_REPS 1
#endif
#define SEAM(k) do { if (IN((k) + 1)) { for (int br_ = 0; br_ < BAR_REPS; ++br_) GRID_BAR(); } } while (0)
#define PHASE_BEGIN() const __attribute__((address_space(4))) Args* ap = (const __attribute__((address_space(4))) Args*)__builtin_amdgcn_kernarg_segment_ptr(); asm volatile("" : "+s"(ap)); const Args args = load_args(ap); \
    int G = G0, bx = bx0, vcu = vcu0; asm volatile("" : "+s"(G), "+s"(bx), "+s"(vcu)); (void)bx; \
    int tid = tid0; asm volatile("" : "+v"(tid)); const int lane = tid & 63; const int wave = __builtin_amdgcn_readfirstlane(tid >> 6); (void)lane; (void)wave; \
    unsigned char* ws = args.ws; unsigned* ctl = (unsigned*)(ws + WS_CTL); (void)ctl; bf16_t* const H = (bf16_t*)(ws + WS_H); (void)H; bf16_t* const X = (bf16_t*)(ws + WS_XB); (void)X; unsigned char* const OUTB = (unsigned char*)args.out; (void)OUTB; u32x2* const RINFO = (u32x2*)(ws + WS_RINFO); (void)RINFO;

template <int l>
__device__ __forceinline__ void run_layer(LAS unsigned char* lds, const int tid0, const int G0, const int bx0, const int vcu0, const int lo, const int hi, const XcdBarrier& bar) {
        constexpr int s0 = 1 + 10 * l; constexpr bool moe = (l & 1) != 0; constexpr int jj = l >> 1;
        if ((PHMASK & 2u) && IN(s0 + 0)) { for (int rep_ = 0; rep_ < REPS(1); ++rep_) { PHASE_BEGIN(); asm volatile("; ==PH 1");
            const float* gain = args.in[I_NMG] + l * DM;
            bf16_t* const HF = (bf16_t*)(ws + WS_HF); signed char* const H8 = (signed char*)(ws + WS_H); float* const SH = (float*)(ws + WS_H + H_SH);
            if constexpr (l == 0) norm1_pair_phase<false>(args.in[I_X], nullptr, nullptr, gain, H8, SH, HF, vcu, G, wave, lane);
            else if constexpr (l == 2) norm1_pair_phase<true>(X, (const bf16_t*)(ws + WS_Y1), X, gain, H8, SH, HF, vcu, G, wave, lane);
            else norm1_pair_phase<true>(X, nullptr, nullptr, gain, H8, SH, HF, vcu, G, wave, lane);
            }
            SEAM(s0 + 0);
        }
        if ((PHMASK & 4u) && IN(s0 + 1)) { for (int rep_ = 0; rep_ < REPS(2); ++rep_) { PHASE_BEGIN(); asm volatile("; ==PH 2");
            const char* WINl = (const char*)(ws + WS_WIN + (size_t)l * WIN_SLOT);
            { pg8::SchedIn S; S.tm.init(NTOK / 256, 32, G, bx); S.A = (const char*)H; S.Bt = WINl;
              pg8::EpiIn E{(bf16_t*)(ws + WS_QKV), (bf16_t*)(ws + WS_UP), (bf16_t*)(ws + WS_GATES), args.in[I_QG] + l * 128, args.in[I_KG] + l * 128, (LAS float*)(lds + 131072), (const float*)(ws + WS_H + H_SH), (const float*)(WINl + WIN_SW)};
              pg8::gemm_phase<pg8::EpiIn, pg8::SchedIn, 1024, 1024, 1024, false, 2>(lds, S, E, tid); }
            { pg8::SchedFour S; S.A = (const char*)(ws + WS_HF); S.Bt = WINl + WIN_F; S.G = G; S.c = bx;
              pg8::EpiYtf E{(unsigned char*)(ws + WS_YT)};
              pg8::gemm_phase<pg8::EpiYtf, pg8::SchedFour, 1024, 1024, 1024, true>(lds, S, E, tid); }
            }
            SEAM(s0 + 1);
        }
        if ((PHMASK & 8u) && IN(s0 + 2)) { for (int rep_ = 0; rep_ < REPS(3); ++rep_) { PHASE_BEGIN(); asm volatile("; ==PH 3");
            { pg8::SchedDFT S; S.DS = (const char*)(ws + WS_DS); S.Yt = (const char*)(ws + WS_YT); S.G = G; S.c = bx;
              pg8::EpiDFT E{(bf16_t*)(ws + WS_SLAB)};
              pg8::gemm_phase<pg8::EpiDFT, pg8::SchedDFT, 2048, 4096, 4096, false, 1>(lds, S, E, tid); }
            __syncthreads();
            { int tid2 = tid; asm volatile("" : "+v"(tid2)); const int lane2 = tid2 & 63, wave2 = __builtin_amdgcn_readfirstlane(tid2 >> 6);
              attn_phase(lds, (const bf16_t*)(ws + WS_QKV), args.in[I_RELB], (bf16_t*)(ws + WS_OG), (float*)(ws + WS_LSE), vcu, G, tid2, wave2, lane2);
              t2048_phase((const signed char*)(ws + WS_H), (const float*)(ws + WS_H + H_SH), (const bf16_t*)(ws + WS_WIN + (size_t)l * WIN_SLOT + WIN_F), (float*)(ws + WS_T2048), vcu, G, wave2, lane2);
              pool_phase((const bf16_t*)(ws + WS_UP), (bf16_t*)(ws + WS_PD), vcu, G, wave2, lane2); }
            }
            SEAM(s0 + 2);
        }
        if ((PHMASK & 16u) && IN(s0 + 3)) { PHASE_BEGIN(); asm volatile("; ==PH 4");
            combine_phase((const bf16_t*)(ws + WS_OG), (const float*)(ws + WS_LSE), (bf16_t*)(ws + WS_ATTN), vcu, G, tid);
            dft_combine_phase((const bf16_t*)(ws + WS_SLAB), (const float*)(ws + WS_T2048), (const unsigned char*)(ws + WS_YT), (bf16_t*)(ws + WS_FOUR), vcu, G, tid, wave, lane);
            SEAM(s0 + 3);
        }
        if ((PHMASK & 32u) && IN(s0 + 5)) { for (int rep_ = 0; rep_ < REPS(5); ++rep_) { PHASE_BEGIN(); asm volatile("; ==PH 5");
            pg8::SchedBranch S; S.tm.init(NTOK / 256, 4, G, bx); S.ws = (const char*)ws;
            S.W = (const char*)((const bf16_t*)(ws + WS_WB) + (size_t)l * 3 * 1024 * 512);
            pg8::EpiBranch E{(const unsigned char*)(ws + WS_GATES), (bf16_t*)(ws + WS_MERGED)};
            pg8::gemm_phase<pg8::EpiBranch, pg8::SchedBranch, 512, 512, 512>(lds, S, E, tid);
            }
            SEAM(s0 + 5);
        }
        if ((PHMASK & 64u) && IN(s0 + 6)) { for (int rep_ = 0; rep_ < REPS(6); ++rep_) { PHASE_BEGIN(); asm volatile("; ==PH 6");
            pg8::SchedPlain S; S.init((const bf16_t*)(ws + WS_MERGED), 1024, (const bf16_t*)(ws + WS_WO) + (size_t)l * 1024 * 1024, 1024, NTOK, 1024, G, bx);
            pg8::EpiRes<l != 0> E{l == 0 ? (const void*)args.in[I_X] : (const void*)X, X, 1.0f};
            pg8::gemm_phase<pg8::EpiRes<l != 0>, pg8::SchedPlain, 1024, 1024, 1024>(lds, S, E, tid);
            }
            SEAM(s0 + 6);
        }
        constexpr bool f8 = moe && ((MOE_F8_MASK >> jj) & 1) != 0; constexpr bool f8d = !moe && ((DENSE_F8_MASK >> jj) & 1) != 0; constexpr bool i8d = !moe && ((DENSE_UP8_MASK >> jj) & 1) != 0;
        if ((PHMASK & 128u) && IN(s0 + 7)) { for (int rep_ = 0; rep_ < REPS(7); ++rep_) { PHASE_BEGIN(); asm volatile("; ==PH 7");
            const float* gain = args.in[I_NFG] + l * DM;
            if constexpr (!moe) norm_phase<i8d ? 2 : (f8d ? 1 : 0)>(X, gain, H, (float*)(ws + WS_H + H_SH), vcu, G, wave, lane);
            else {
                norm_router_phase<f8>(X, gain, args.in[I_RW] + (size_t)jj * 1024 * 8, args.in[I_RB] + jj * 8, H, ctl + CW_GCNT + jj * 16, RINFO, (unsigned long long*)(ctl + CW_GRAN) + jj * 2048, (unsigned)jj + 1u, lds, vcu, G, tid, wave, lane);
                LAS float* scr = (LAS float*)(lds + wave * 16384);
                const int gw = vcu * NWAVES + wave, NGW = G * NWAVES;
                const float* mw1 = args.in[I_MW1] + (size_t)jj * 8 * 1024 * ED; const float* mw3 = args.in[I_MW3] + (size_t)jj * 8 * 1024 * ED;
                for (int sr_ = 0; sr_ < 1 + SUBREP_C; ++sr_)
                if constexpr (f8) {
                    cvt_w13_8(mw1, mw3, ED, 8, OUTB, F8_SW, scr, gw, NGW, lane);
                    for (int e = 0; e < 8; ++e) cvt_plain8(args.in[I_MW2] + ((size_t)jj * 8 + e) * ED * 1024, 1024, ED, (unsigned char*)(ws + WS_WM2) + (size_t)e * 1024 * ED, 1024, F8_SW, scr, gw, NGW, lane);
                } else {
                    cvt_w13(mw1, mw3, ED, 8, (bf16_t*)OUTB, scr, gw, NGW, lane);
                    for (int e = 0; e < 8; ++e) cvt_plain(args.in[I_MW2] + ((size_t)jj * 8 + e) * ED * 1024, 1024, ED, (bf16_t*)(ws + WS_WM2) + (size_t)e * 1024 * ED, 0, 1024, 0, scr, gw, NGW, lane);
                }
            }
            }
            SEAM(s0 + 7);
        }
        if ((PHMASK & 256u) && IN(s0 + 8)) { for (int rep_ = 0; rep_ < REPS(8); ++rep_) { PHASE_BEGIN(); asm volatile("; ==PH 8");
            if constexpr (!moe) {
                pg8::SchedPlain S; S.init(H, 1024, (const void*)(ws + WS_W13 + (size_t)jj * W13_SLOT), 1024, NTOK, 2 * FF, G, bx, (f8d || i8d) ? 1 : 2);
                pg8::EpiSwiglu<f8d, i8d> E{(void*)(ws + WS_ACT), FF, f8d ? 1.0f / F8_SW : 1.0f, f8d ? F8_SACT : 1.0f, (const float*)(ws + WS_H + H_SH), (const float*)(ws + WS_W13 + (size_t)jj * W13_SLOT + W13_SW)};
                pg8::gemm_phase<pg8::EpiSwiglu<f8d, i8d>, pg8::SchedPlain, 1024, 1024, 1024, false, i8d ? 2 : (f8d ? 1 : 0)>(lds, S, E, tid);
            } else {
                pg8::moe_tiles_setup((LAS int*)(lds + MISC_OFF + 3328), ctl + CW_GCNT + jj * 16, tid);
                pg8::SchedMoeUp<f8 ? 1 : 2> S; S.mt.t = (const LAS int*)(lds + MISC_OFF + 3328); S.tm.init(S.mt.total(), 28, G, bx); S.H = (const char*)H; S.W13 = (const char*)OUTB; S.rinfo = RINFO;
                pg8::EpiSwiglu<f8> E{(void*)(ws + WS_ACT), ED, f8 ? 1.0f / F8_SW : 1.0f, f8 ? F8_SACT : 1.0f, nullptr, nullptr};
                pg8::gemm_phase<pg8::EpiSwiglu<f8>, pg8::SchedMoeUp<f8 ? 1 : 2>, 1024, 1024, 1024, false, f8 ? 1 : 0>(lds, S, E, tid);
            }
            }
            SEAM(s0 + 8);
        }
        if ((PHMASK & 512u) && IN(s0 + 9)) { for (int rep_ = 0; rep_ < REPS(9); ++rep_) { PHASE_BEGIN(); asm volatile("; ==PH 9");
            if constexpr (!moe) {
                pg8::SchedPlain S; S.init((const bf16_t*)(ws + WS_ACT), FF, (const bf16_t*)(ws + WS_W2) + (size_t)jj * 1024 * FF, FF, NTOK, 1024, G, bx, f8d ? 1 : 2);
                pg8::EpiRes<true> E{X, X, f8d ? 1.0f / (F8_SW * F8_SACT) : 1.0f};
                pg8::gemm_phase<pg8::EpiRes<true>, pg8::SchedPlain, FF, FF, FF, false, f8d ? 1 : 0>(lds, S, E, tid);
            } else {
                pg8::moe_tiles_setup((LAS int*)(lds + MISC_OFF + 3328), ctl + CW_GCNT + jj * 16, tid);
                pg8::SchedMoeDown<f8 ? 1 : 2> S; S.mt.t = (const LAS int*)(lds + MISC_OFF + 3328); S.tm.init(S.mt.total(), 4, G, bx); S.ACT = (const char*)(ws + WS_ACT); S.W2 = (const char*)(ws + WS_WM2);
                const int nwg_ = S.mt.total() * 4; int lim_ = (nwg_ / G) * G, ntail_ = nwg_ - lim_; if (lim_ == 0 || ntail_ > MOE_TAIL_MAX) { lim_ = nwg_; ntail_ = 0; }
                S.lim = lim_;
                pg8::EpiMoeDown E{X, (bf16_t*)(ws + WS_Y1), RINFO, S.mt, f8 ? 1.0f / (F8_SW * F8_SACT) : 1.0f};
                pg8::gemm_phase<pg8::EpiMoeDown, pg8::SchedMoeDown<f8 ? 1 : 2>, ED, ED, ED, false, f8 ? 1 : 0>(lds, S, E, tid);
                if (ntail_ > 0) {
                    pg8::SchedMoeDownTail<f8 ? 1 : 2, MOE_KS> ST; ST.tm = S.tm; ST.mt = S.mt; ST.ACT = S.ACT; ST.W2 = S.W2; ST.lim = lim_; ST.ntail = ntail_;
                    pg8::EpiMoeDownTail<MOE_KS> ET{E, (float*)OUTB, ctl + CW_TAIL + jj * 64, (LAS int*)(lds + MISC_OFF + 3328) + 31};
                    pg8::gemm_phase<pg8::EpiMoeDownTail<MOE_KS>, pg8::SchedMoeDownTail<f8 ? 1 : 2, MOE_KS>, ED / MOE_KS, ED, ED, false, f8 ? 1 : 0>(lds, ST, ET, tid);
                }
            }
            }
            SEAM(s0 + 9);
        }
    }

__global__ void __launch_bounds__(NTHR, 2) fwd_kernel(Args args_by_value) {
    extern __shared__ __attribute__((aligned(16))) unsigned char lds_raw[];
    LAS unsigned char* lds = (LAS unsigned char*)lds_raw;
    const int tid0 = threadIdx.x;
    const int G0 = gridDim.x; const int bx0 = blockIdx.x; const int vcu0 = (G0 % 8 == 0) ? (bx0 % 8) * (G0 / 8) + bx0 / 8 : bx0;
    volatile LAS unsigned* MISC = (volatile LAS unsigned*)(lds + MISC_OFF);
    if (tid0 < 16) MISC[tid0] = 0u;
    __syncthreads();
#if ONE_LAUNCH
    XcdBarrier bar = xcd_barrier_post((unsigned*)(args_by_value.ws + WS_CTL) + CW_BAR, MISC);
#else
    XcdBarrier bar; bar.bar = nullptr; bar.x = 0; bar.st = MISC;
#endif
    const int lo = args_by_value.ph_lo, hi = args_by_value.ph_hi;
    if ((PHMASK & 1u) && IN(0)) { for (int rep_ = 0; rep_ < REPS(0); ++rep_) { PHASE_BEGIN(); asm volatile("; ==PH 0"); prologue_phase(args, lds, vcu, G, tid, wave, lane); __syncthreads(); }   }
    run_layer<0>(lds, tid0, G0, bx0, vcu0, lo, hi, bar);
    run_layer<1>(lds, tid0, G0, bx0, vcu0, lo, hi, bar);
    run_layer<2>(lds, tid0, G0, bx0, vcu0, lo, hi, bar);
    run_layer<3>(lds, tid0, G0, bx0, vcu0, lo, hi, bar);
    if ((PHMASK & 1024u) && IN(41)) { PHASE_BEGIN(); add_phase(args.out, X, (const bf16_t*)(ws + WS_Y1), vcu, G, tid); }
#undef IN
#undef SEAM
}

extern "C" void kernel_launch(void* const* d_in, const int* in_sizes, int n_in, void* d_out, int out_size, void* d_ws, size_t ws_size, hipStream_t stream) {
    static int grid = 0;
    if (grid == 0) {
        if (n_in != 21 || in_sizes[0] != NTOK * DM || out_size != NTOK * DM || ws_size < WS_END) {
            fprintf(stderr, "kernel_launch: unexpected problem (n_in %d, in0 %d, out %d, ws %zu < %zu?); nothing launched\n", n_in, n_in > 0 ? in_sizes[0] : -1, out_size, ws_size, (size_t)WS_END); grid = -1; return; }
        int dev = 0, cus = 0, per_cu = 0;
        if (hipGetDevice(&dev) != hipSuccess || hipDeviceGetAttribute(&cus, hipDeviceAttributeMultiprocessorCount, dev) != hipSuccess) { grid = -1; return; }
        if (hipFuncSetAttribute((const void*)fwd_kernel, hipFuncAttributeMaxDynamicSharedMemorySize, LDS_BYTES) != hipSuccess) { fprintf(stderr, "kernel_launch: hipFuncSetAttribute failed\n"); grid = -1; return; }
        if (hipOccupancyMaxActiveBlocksPerMultiprocessor(&per_cu, (const void*)fwd_kernel, NTHR, LDS_BYTES) != hipSuccess || per_cu < 1) { fprintf(stderr, "kernel_launch: occupancy query reports %d\n", per_cu); }
        (void)hipGetLastError();
        grid = cus;
    }
    if (grid < 0) return;
    (void)hipMemsetAsync((char*)d_ws + WS_CTL, 0, CTL_ZERO_BYTES, stream);
    Args a{};
    for (int i = 0; i < 21; ++i) a.in[i] = (const float*)d_in[i];
    a.out = (float*)d_out; a.ws = (unsigned char*)d_ws;
#if ONE_LAUNCH
    a.ph_lo = 0; a.ph_hi = NSTEPS;
    hipLaunchKernelGGL(fwd_kernel, dim3(grid), dim3(NTHR), LDS_BYTES, stream, a);
#else
    for (int s = 0; s < NSTEPS; ++s) { a.ph_lo = s; a.ph_hi = s + 1; hipLaunchKernelGGL(fwd_kernel, dim3(grid), dim3(NTHR), LDS_BYTES, stream, a); }
#endif
}
```

```cpp
#include <hip/hip_runtime.h>
#include <cstdio>
#include <cstdint>
#include <cmath>

#ifndef MOE_F8_MASK
#define MOE_F8_MASK 3
#endif
#ifndef DENSE_UP8_MASK
#define DENSE_UP8_MASK 3
#endif
#ifndef DENSE_F8_MASK
#define DENSE_F8_MASK 2
#endif
#define F8_SW 64.0f
#define F8_SACT 8.0f
#define DFT_SA 16384.0f
#define DFT_SY 16.0f
#ifndef PROL_A
#define PROL_A 0
#define PROL_C 0
#endif
#ifndef ONE_LAUNCH
#define ONE_LAUNCH 1
#endif

#define LAS __attribute__((address_space(3)))
#define GAS __attribute__((address_space(1)))
typedef unsigned short bf16_t;
typedef short bf16x8 __attribute__((ext_vector_type(8)));
typedef short s16x4 __attribute__((ext_vector_type(4)));
typedef float f32x4 __attribute__((ext_vector_type(4)));
typedef float f32x2 __attribute__((ext_vector_type(2)));
typedef unsigned u32x4 __attribute__((ext_vector_type(4)));
typedef unsigned u32x2 __attribute__((ext_vector_type(2)));
typedef __bf16 bf16x2_t __attribute__((ext_vector_type(2)));
typedef int i32x8 __attribute__((ext_vector_type(8)));
typedef int i32x4 __attribute__((ext_vector_type(4)));

constexpr int DM = 1024, NTOK = 32768, SEQ = 4096, NBATCH = 8, DEPTH = 4;
constexpr int SRC_IN = 8704;
constexpr int INW = 9216;
constexpr int QKVW = 4608;
constexpr int FF = 2816, NE = 8, ED = 3584;
constexpr float RMS_EPS = 1e-6f;
constexpr int NWAVES = 8, NTHR = 512;

constexpr size_t MiB = 1u << 20;
constexpr size_t WS_CTL = 0, CTL_ZERO_BYTES = 1 * MiB;
constexpr size_t WS_RINFO = 1 * MiB;
constexpr size_t WS_DS = 8 * MiB;
constexpr size_t WS_T2048 = 44 * MiB;
constexpr size_t WS_WIN = 72 * MiB;
constexpr size_t WIN_SLOT = 18 * MiB, WIN_SW = 8 * MiB, WIN_F = 10 * MiB;
constexpr size_t WS_WB = 144 * MiB;
constexpr size_t WS_WO = 156 * MiB;
constexpr size_t W13_SLOT = 11 * MiB, W13_SW = 6 * MiB;
constexpr size_t WS_W13 = 164 * MiB;
constexpr size_t WS_W2 = 186 * MiB;
constexpr size_t WS_H = 200 * MiB;
constexpr size_t H_SH = 32 * MiB;
constexpr size_t WS_QKV = 264 * MiB;
constexpr size_t WS_HF = 552 * MiB;
constexpr size_t WS_UP = 616 * MiB;
constexpr size_t WS_GATES = 648 * MiB;
constexpr size_t WS_OG = 840 * MiB;
constexpr size_t WS_YT = 936 * MiB;
constexpr size_t WS_PD = 1000 * MiB;
constexpr size_t WS_LSE = 1032 * MiB;
constexpr size_t WS_END = 1034 * MiB;
constexpr size_t WS_ATTN = 264 * MiB;
constexpr size_t WS_FOUR = 296 * MiB;
constexpr size_t WS_MERGED = 328 * MiB;
constexpr size_t WS_SLAB = 456 * MiB;
constexpr size_t WS_ACT = 264 * MiB;
constexpr size_t WS_XB = 744 * MiB;
constexpr size_t WS_WM2 = 838 * MiB;
constexpr size_t WS_Y1 = 894 * MiB;
static_assert(WS_Y1 + (size_t)NTOK * DM * 2 <= WS_END, "ws map");
constexpr int CW_TMO = 0;
constexpr int CW_BAR = 4096;
constexpr int CW_GCNT = 8192;
constexpr int CW_GRAN = 16384;
constexpr int CW_TAIL = 12288;
constexpr int MOE_KS = 7, MOE_TAIL_MAX = 64;

constexpr int LDS_BYTES = 147456;
constexpr int AT_K = 0, AT_V = 65536;
constexpr int BT_OFF = 135168;
constexpr int MISC_OFF = 142848;

#define LDS_WAIT() asm volatile("s_waitcnt lgkmcnt(0)" ::: "memory")
#define VM_WAIT() asm volatile("s_waitcnt vmcnt(0)" ::: "memory")
__device__ __forceinline__ unsigned pk2(float lo, float hi) { f32x2 v = {lo, hi}; bf16x2_t r = __builtin_convertvector(v, bf16x2_t); return __builtin_bit_cast(unsigned, r); }
__device__ __forceinline__ float clamp8(float v) { return __builtin_amdgcn_fmed3f(v, -448.0f, 448.0f); }
__device__ __forceinline__ unsigned pk8x4(float a, float b, float c, float d) {
    int p = __builtin_amdgcn_cvt_pk_fp8_f32(clamp8(a), clamp8(b), 0, false); p = __builtin_amdgcn_cvt_pk_fp8_f32(clamp8(c), clamp8(d), p, true); return (unsigned)p; }
__device__ __forceinline__ unsigned pk8x4_nc(float a, float b, float c, float d) {
    int p = __builtin_amdgcn_cvt_pk_fp8_f32(a, b, 0, false); p = __builtin_amdgcn_cvt_pk_fp8_f32(c, d, p, true); return (unsigned)p; }
__device__ __forceinline__ float bf_lo(unsigned u) { return __uint_as_float(u << 16); }
__device__ __forceinline__ float bf_hi(unsigned u) { return __uint_as_float(u & 0xffff0000u); }
template <bool BF> __device__ __forceinline__ f32x4 ldx4(const void* p, size_t i4) {
    if constexpr (BF) { const u32x2 w = ((const u32x2*)p)[i4]; return (f32x4){bf_lo(w.x), bf_hi(w.x), bf_lo(w.y), bf_hi(w.y)}; }
    else return ((const f32x4*)p)[i4];
}
template <bool BF> __device__ __forceinline__ void ldx8(const void* p, size_t i8, f32x4& a, f32x4& b) {
    if constexpr (BF) { const u32x4 w = ((const u32x4*)p)[i8]; a = (f32x4){bf_lo(w.x), bf_hi(w.x), bf_lo(w.y), bf_hi(w.y)}; b = (f32x4){bf_lo(w.z), bf_hi(w.z), bf_lo(w.w), bf_hi(w.w)}; }
    else { a = ((const f32x4*)p)[2 * i8]; b = ((const f32x4*)p)[2 * i8 + 1]; }
}
__device__ __forceinline__ void stx8(bf16_t* p, size_t i8, const f32x4 a, const f32x4 b) { u32x4 w; w.x = pk2(a.x, a.y); w.y = pk2(a.z, a.w); w.z = pk2(b.x, b.y); w.w = pk2(b.z, b.w); ((u32x4*)p)[i8] = w; }
__device__ __forceinline__ void stx4(bf16_t* p, size_t i4, const f32x4 v) { u32x2 w; w.x = pk2(v.x, v.y); w.y = pk2(v.z, v.w); ((u32x2*)p)[i4] = w; }
__device__ __forceinline__ float wave_sum(float v) {
#pragma unroll
    for (int o = 1; o < 64; o <<= 1) v += __shfl_xor(v, o);
    return v;
}
__device__ __forceinline__ float fast_exp(float x) { return __builtin_amdgcn_exp2f(x * 1.4426950408889634f); }
__device__ __forceinline__ float sigmoidf_(float x) { return __builtin_amdgcn_rcpf(1.0f + fast_exp(-x)); }

#define XB_TMO      128
#define XB_XCNT(j)  (256  + 64 * (j))
#define XB_XSUB(j)  (1280 + 64 * (j))
#define XB_XGEN(j)  (2304 + 64 * (j))
#define XB_TOP      3328
#define XB_TOPGEN   3392
#define XCD_BAR_WORDS 3456
#define XB_SPIN_CAP (1u << 18)
__device__ __forceinline__ unsigned xb_ld(unsigned* p)              { return __hip_atomic_load(p, __ATOMIC_RELAXED, __HIP_MEMORY_SCOPE_AGENT); }
__device__ __forceinline__ unsigned xb_add(unsigned* p, unsigned v) { return __hip_atomic_fetch_add(p, v, __ATOMIC_RELAXED, __HIP_MEMORY_SCOPE_AGENT); }
__device__ __forceinline__ unsigned xb_xcc_id() { return (unsigned)__builtin_amdgcn_s_getreg((3 << 11) | 20) & 0xFu; }
#define XB_SPIN(cond, bar) do { unsigned _sp = 0; while (cond) { __builtin_amdgcn_s_sleep(1); \
    if ((++_sp & 255u) == 0u) { if (xb_ld(&(bar)[XB_TMO])) break; if (_sp > XB_SPIN_CAP) { atomicAdd(&(bar)[XB_TMO], 1u); break; } } } } while (0)
struct XcdBarrier { unsigned* bar; unsigned x; volatile LAS unsigned* st; };
__device__ __forceinline__ XcdBarrier xcd_barrier_post(unsigned* bar, volatile LAS unsigned* st) {
    XcdBarrier b; b.bar = bar; b.x = xb_xcc_id(); b.st = st;
    if (threadIdx.x == 0) (void)xb_add(&bar[XB_XCNT(b.x)], 1u);
    return b;
}
__device__ __forceinline__ void xcd_barrier_complete(unsigned* bar, unsigned x, unsigned& nloc, unsigned& nx) {
    const unsigned G = gridDim.x * gridDim.y * gridDim.z;
    unsigned sum, cnt, mine, sp = 0u;
    for (;;) {
        sum = 0u; cnt = 0u; mine = 0u;
#pragma unroll
        for (unsigned j = 0; j < 16; ++j) { const unsigned c = xb_ld(&bar[XB_XCNT(j)]); sum += c; cnt += (c > 0u) ? 1u : 0u; mine = (j == x) ? c : mine; }
        if (sum == G) break;
        __builtin_amdgcn_s_sleep(1);
        if ((++sp & 255u) == 0u) { if (xb_ld(&bar[XB_TMO])) break; if (sp > XB_SPIN_CAP) { atomicAdd(&bar[XB_TMO], 1u); break; } }
    }
    nloc = mine > 0u ? mine : 1u; nx = cnt > 0u ? cnt : 1u;
}
__device__ __forceinline__ void xcd_barrier(const XcdBarrier& b) {
    asm volatile("s_waitcnt vmcnt(0)" ::: "memory");
    __syncthreads();
    if (threadIdx.x == 0) {
        unsigned* bar = b.bar;
        __builtin_amdgcn_s_waitcnt(0);
        asm volatile("buffer_inv sc1" ::: "memory");
        unsigned nloc = b.st[0], nx = b.st[1];
        if (nloc == 0u) { xcd_barrier_complete(bar, b.x, nloc, nx); b.st[0] = nloc; b.st[1] = nx; }
        const unsigned old = xb_add(&bar[XB_XSUB(b.x)], 1u);
        const unsigned gen = old / nloc;
        if (old + 1u == (gen + 1u) * nloc) {
            __builtin_amdgcn_fence(__ATOMIC_RELEASE, "agent");
            asm volatile("s_waitcnt vmcnt(0)" ::: "memory");
            const unsigned og = xb_add(&bar[XB_TOP], 1u);
            const unsigned tg = og / nx;
            if (og + 1u == (tg + 1u) * nx) xb_add(&bar[XB_TOPGEN], 1u);
            else XB_SPIN(xb_ld(&bar[XB_TOPGEN]) == tg, bar);
            asm volatile("" ::: "memory");
            xb_add(&bar[XB_XGEN(b.x)], 1u);
            asm volatile("s_waitcnt vmcnt(0)" ::: "memory");
        } else {
            XB_SPIN(xb_ld(&bar[XB_XGEN(b.x)]) == gen, bar);
            asm volatile("s_waitcnt vmcnt(0)" ::: "memory");
        }
    }
    __syncthreads();
}

namespace pg8 {
constexpr int BM = 256, BK = 64, HALF = 128, HTB = HALF * BK * 2, STAGE_BYTES = 8 * HTB, NXCD = 8, WGM = 4;
__host__ __device__ __forceinline__ int lds_byte(int r, int c) { const int st = (r >> 4) * 2 + (c >> 5), rr = r & 15, cc = c & 31, ob = rr * 64 + cc * 2; return st * 1024 + (ob ^ (((ob >> 9) & 1) << 5)); }
__host__ __device__ __forceinline__ void stage_rc(int b, int& R, int& C) { const int st = b / 1024, sb = b % 1024, swz = sb ^ (((sb >> 9) & 1) << 5); R = (st >> 1) * 16 + swz / 64; C = (st & 1) * 32 + (swz % 64) / 2; }
__host__ __device__ __forceinline__ int perm32(int rho) { const int n = rho >> 4, i = rho & 15; return 8 * (i >> 2) + 4 * n + (i & 3); }

struct Unit { int pm, pn, e, lt; };
struct GemmP { int K, lda, ldb; };

struct TileMap {
    int nM, nN, nwg, G, c;
    __device__ __forceinline__ void init(int nM_, int nN_, int G_, int c_) { nM = nM_; nN = nN_; nwg = nM * nN; G = G_; c = c_; }
    __device__ __forceinline__ bool map(int i, int& pm, int& pn) const { return map_L((long)i * G + c, pm, pn); }
    __device__ __forceinline__ bool map_L(const long L, int& pm, int& pn) const {
        if (L >= nwg) return false;
        int wgid = (int)L; { const int q = nwg / NXCD, r = nwg % NXCD, xcd = wgid % NXCD, off = wgid / NXCD; wgid = (xcd < r ? xcd * (q + 1) : r * (q + 1) + (xcd - r) * q) + off; }
        const int nig = WGM * nN, gid = wgid / nig, fm = gid * WGM, gsz = (nM - fm) < WGM ? (nM - fm) : WGM;
        pm = fm + ((wgid % nig) % gsz); pn = (wgid % nig) / gsz; return true;
    }
};

template <class Epi, class Sched, int KDIM, int LDA, int LDB, bool SWAP = false, int QM = 0>
__device__ __forceinline__ void gemm_phase(LAS unsigned char* lds, const Sched& S, const Epi& E, const int tid) {
    constexpr bool GA = Sched::GATHER; constexpr bool ALIGN_EPI = true, SP2 = true; constexpr GemmP g{KDIM, LDA, LDB};
    const int wid = __builtin_amdgcn_readfirstlane(tid >> 6), lane = tid & 63, wr = wid >> 2, wc = wid & 3, fr = lane & 15, fq = lane >> 4;
    constexpr bool F8 = QM == 1, I8 = QM == 2; constexpr int ES = QM ? 1 : 2;
    const int nt = (g.K * ES) / (BK * 2);
    unsigned voffA[2][2], nvoffA[2][2], voffB[2]; int stR[2], stC[2];
#pragma unroll
    for (int i = 0; i < 2; ++i) { int R, C; stage_rc(tid * 16 + i * 8192, R, C); stR[i] = R; stC[i] = C; const int Rb = Epi::PERM ? ((R & ~31) + perm32(R & 31)) : R;
        voffA[0][i] = (unsigned)(R * g.lda * ES + C * 2); voffA[1][i] = voffA[0][i]; nvoffA[0][i] = voffA[0][i]; nvoffA[1][i] = voffA[0][i]; voffB[i] = (unsigned)(Rb * g.ldb * ES + C * 2); }
    const size_t kstep = (size_t)(BK * 2);
    const size_t hstepA = (size_t)HALF * g.lda * ES, hstepB = (size_t)HALF * g.ldb * ES;
    const unsigned ldsw = (unsigned)wid * 1024u;
    const int aoff = lds_byte(wr * 64 + fr, fq * 8), boff = lds_byte(wc * 32 + fr, fq * 8);
#define PG8_SA(b, h) (((b) * 2 + (h)) * HTB)
#define PG8_SB(b, h) ((4 + (b) * 2 + (h)) * HTB)
#define PG8_STAGE_B(bufoff, gbase) do { _Pragma("unroll") for (int _i = 0; _i < 2; ++_i) \
        __builtin_amdgcn_global_load_lds((const unsigned*)((const char*)(gbase) + voffB[_i]), (LAS unsigned*)(lds + (bufoff) + ldsw + _i * 8192), 16, 0, 0); } while (0)
#define PG8_STAGE_A(bufoff, h, gbase, vo) do { _Pragma("unroll") for (int _i = 0; _i < 2; ++_i) \
        __builtin_amdgcn_global_load_lds((const unsigned*)((const char*)(gbase) + (GA ? (size_t)0 : (size_t)(h) * hstepA) + (vo)[GA ? (h) : 0][_i]), (LAS unsigned*)(lds + (bufoff) + ldsw + _i * 8192), 16, 0, 0); } while (0)
#define PG8_LDA(dst, b, h) do { _Pragma("unroll") for (int m = 0; m < 4; ++m) _Pragma("unroll") for (int k = 0; k < 2; ++k) dst[m][k] = *(const LAS u32x4*)(lds + PG8_SA(b, h) + aoff + m * 2048 + k * 1024); } while (0)
#define PG8_LDB(dst, b, h) do { _Pragma("unroll") for (int n = 0; n < 2; ++n) _Pragma("unroll") for (int k = 0; k < 2; ++k) dst[n][k] = *(const LAS u32x4*)(lds + PG8_SB(b, h) + boff + n * 2048 + k * 1024); } while (0)
#define PG8_MMA(ai, bj, At, Bt) do { __builtin_amdgcn_s_setprio(1); if constexpr (F8) { _Pragma("unroll") for (int m = 0; m < 4; ++m) _Pragma("unroll") for (int n = 0; n < 2; ++n) \
        asm volatile("v_mfma_scale_f32_16x16x128_f8f6f4 %0, %1, %2, %0, %3, %3 op_sel_hi:[0,0,0]" : "+v"(acc[ai][bj][m][n]) \
            : "v"(__builtin_bit_cast(i32x8, __builtin_shufflevector(Bt[n][0], Bt[n][1], 0, 1, 2, 3, 4, 5, 6, 7))), "v"(__builtin_bit_cast(i32x8, __builtin_shufflevector(At[m][0], At[m][1], 0, 1, 2, 3, 4, 5, 6, 7))), "v"(0x7f7f7f7f)); } else { \
        _Pragma("unroll") for (int m = 0; m < 4; ++m) _Pragma("unroll") for (int n = 0; n < 2; ++n) _Pragma("unroll") for (int k = 0; k < 2; ++k) \
        acc[ai][bj][m][n] = I8 ? __builtin_bit_cast(f32x4, __builtin_amdgcn_mfma_i32_16x16x64_i8(__builtin_bit_cast(i32x4, Bt[n][k]), __builtin_bit_cast(i32x4, At[m][k]), __builtin_bit_cast(i32x4, acc[ai][bj][m][n]), 0, 0, 0)) : SWAP ? __builtin_amdgcn_mfma_f32_16x16x32_bf16(__builtin_bit_cast(bf16x8, At[m][k]), __builtin_bit_cast(bf16x8, Bt[n][k]), acc[ai][bj][m][n], 0, 0, 0) \
                                 : __builtin_amdgcn_mfma_f32_16x16x32_bf16(__builtin_bit_cast(bf16x8, Bt[n][k]), __builtin_bit_cast(bf16x8, At[m][k]), acc[ai][bj][m][n], 0, 0, 0); } __builtin_amdgcn_s_setprio(0); } while (0)
#define PG8_WAIT_V(n) asm volatile("s_waitcnt vmcnt(" #n ")" ::: "memory")
#define PG8_WAIT_V8E asm volatile("s_waitcnt vmcnt(%0)" :: "i"(8 + Epi::NST) : "memory")
#define PG8_WAIT_L(n) asm volatile("s_waitcnt lgkmcnt(" #n ")" ::: "memory")
#define PG8_BAR __builtin_amdgcn_s_barrier()
#define PG8_SCHED __builtin_amdgcn_sched_barrier(0)
#define PG8_SCHED8 do { if constexpr (F8) __builtin_amdgcn_sched_barrier(0); } while (0)
    Unit cur, nxt; int ui = 0;
    if (!S.next(0, cur)) return;
    f32x4 acc[2][2][4][2];
#pragma unroll
    for (int a = 0; a < 2; ++a)
#pragma unroll
        for (int b = 0; b < 2; ++b)
#pragma unroll
            for (int m = 0; m < 4; ++m)
#pragma unroll
                for (int n = 0; n < 2; ++n) acc[a][b][m][n] = (f32x4){0.f, 0.f, 0.f, 0.f};
    u32x4 At[4][2], B0[2][2], B1[2][2];
    const char* cA = S.a_ptr(cur); const char* cB = S.b_ptr(cur);
    if constexpr (GA) S.a_offs(cur, stR, stC, voffA);
    static_assert(SP2, "only the SP2 loop is kept");
    PG8_STAGE_B(PG8_SB(0, 0), cB); PG8_STAGE_B(PG8_SB(0, 1), cB + hstepB); PG8_STAGE_A(PG8_SA(0, 0), 0, cA, voffA); PG8_STAGE_A(PG8_SA(0, 1), 1, cA, voffA);
    if (wr == 1) PG8_BAR;
    PG8_WAIT_V(2); PG8_BAR;
    PG8_STAGE_B(PG8_SB(1, 0), cB + kstep); PG8_STAGE_A(PG8_SA(1, 0), 0, cA + kstep, voffA); PG8_STAGE_B(PG8_SB(1, 1), cB + hstepB + kstep);
    if constexpr (Epi::NST > 0) { PG8_WAIT_V(0); } else { PG8_WAIT_V(6); }
    PG8_BAR;
    for (;;) {
        const bool has_next = S.next(ui + 1, nxt);
        const char* nA = has_next ? S.a_ptr(nxt) : cA; const char* nB = has_next ? S.b_ptr(nxt) : cB;
        if constexpr (GA) { if (has_next) S.a_offs(nxt, stR, stC, nvoffA); else {
#pragma unroll
            for (int h = 0; h < 2; ++h)
#pragma unroll
                for (int i = 0; i < 2; ++i) nvoffA[h][i] = voffA[h][i]; } }
#define PG8_TRIP(t, WA) do { \
            const bool last = ((t) == nt - 2); \
            const char* a1 = cA + (size_t)((t) + 1) * kstep; \
            const char* a2 = last ? nA : cA + (size_t)((t) + 2) * kstep; const char* b2 = last ? nB : cB + (size_t)((t) + 2) * kstep; \
            const char* a3 = a2 + kstep; const char* b3 = b2 + kstep; \
            unsigned v2[2][2]; \
            _Pragma("unroll") for (int h = 0; h < 2; ++h) _Pragma("unroll") for (int i = 0; i < 2; ++i) v2[h][i] = (GA && last) ? nvoffA[h][i] : voffA[h][i]; \
            PG8_LDB(B0, 0, 0); PG8_LDB(B1, 0, 1); PG8_SCHED; PG8_LDA(At, 0, 0); PG8_STAGE_A(PG8_SA(1, 1), 1, a1, voffA); \
            WA; PG8_WAIT_L(0); PG8_BAR; PG8_SCHED8; PG8_MMA(0, 0, At, B0); PG8_MMA(0, 1, At, B1); PG8_SCHED8; PG8_BAR; PG8_SCHED; \
            PG8_LDA(At, 0, 1); PG8_STAGE_B(PG8_SB(0, 0), b2); PG8_STAGE_B(PG8_SB(0, 1), b2 + hstepB); PG8_STAGE_A(PG8_SA(0, 0), 0, a2, v2); \
            WA; PG8_WAIT_L(0); PG8_BAR; PG8_SCHED8; PG8_MMA(1, 0, At, B0); PG8_MMA(1, 1, At, B1); PG8_SCHED8; PG8_BAR; PG8_SCHED; \
            PG8_LDB(B0, 1, 0); PG8_LDB(B1, 1, 1); PG8_SCHED; PG8_LDA(At, 1, 0); PG8_STAGE_A(PG8_SA(0, 1), 1, a2, v2); \
            PG8_WAIT_V(8); PG8_WAIT_L(0); PG8_BAR; PG8_SCHED8; PG8_MMA(0, 0, At, B0); PG8_MMA(0, 1, At, B1); PG8_SCHED8; PG8_BAR; PG8_SCHED; \
            PG8_LDA(At, 1, 1); PG8_STAGE_B(PG8_SB(1, 0), b3); PG8_STAGE_B(PG8_SB(1, 1), b3 + hstepB); PG8_STAGE_A(PG8_SA(1, 0), 0, a3, v2); \
            PG8_WAIT_V(8); PG8_WAIT_L(0); PG8_BAR; PG8_SCHED8; PG8_MMA(1, 0, At, B0); PG8_MMA(1, 1, At, B1); PG8_SCHED8; PG8_BAR; PG8_SCHED; } while (0)
        static_assert((KDIM * ES) / (BK * 2) >= 4, "at least two trips per unit");
        if constexpr (Epi::NST > 0) { PG8_TRIP(0, PG8_WAIT_V8E); asm volatile("" : "+v"(voffB[0]), "+v"(voffB[1]), "+v"(voffA[0][0]), "+v"(voffA[0][1])); for (int t = 2; t < nt; t += 2) PG8_TRIP(t, PG8_WAIT_V(8)); }
        else { for (int t = 0; t < nt; t += 2) PG8_TRIP(t, PG8_WAIT_V(8)); }
#undef PG8_TRIP
        if constexpr (ALIGN_EPI) { if (wr == 0) PG8_BAR; }
        if constexpr (F8) asm volatile("s_nop 15\n\ts_nop 15\n\ts_nop 7" ::: "memory");
        E(acc, cur, wr, wc, fr, fq);
        if (!has_next) break;
        if (!E.keep(cur)) {
#pragma unroll
        for (int a = 0; a < 2; ++a)
#pragma unroll
            for (int b = 0; b < 2; ++b)
#pragma unroll
                for (int m = 0; m < 4; ++m)
#pragma unroll
                    for (int n = 0; n < 2; ++n) acc[a][b][m][n] = (f32x4){0.f, 0.f, 0.f, 0.f}; }
        cur = nxt; cA = nA; cB = nB; ++ui;
        if constexpr (GA) {
#pragma unroll
            for (int h = 0; h < 2; ++h)
#pragma unroll
                for (int i = 0; i < 2; ++i) voffA[h][i] = nvoffA[h][i]; }
        if constexpr (ALIGN_EPI) { if (wr == 1) PG8_BAR; }
    }
    PG8_WAIT_V(0);
    if constexpr (!ALIGN_EPI) { if (wr == 0) PG8_BAR; }
    PG8_BAR;
#undef PG8_SA
#undef PG8_SB
#undef PG8_STAGE_A
#undef PG8_STAGE_B
#undef PG8_LDA
#undef PG8_LDB
#undef PG8_MMA
#undef PG8_WAIT_V
#undef PG8_WAIT_V8E
#undef PG8_WAIT_L
#undef PG8_BAR
#undef PG8_SCHED
#undef PG8_SCHED8
}

struct SchedPlain {
    static constexpr bool GATHER = false;
    TileMap tm; const char* A; const char* Bt; size_t astep, bstep;
    __device__ __forceinline__ void init(const void* A_, int lda, const void* Bt_, int ldb, int M, int N, int G, int c, int es = 2) { tm.init(M / BM, N / BM, G, c); A = (const char*)A_; Bt = (const char*)Bt_; astep = (size_t)BM * lda * es; bstep = (size_t)BM * ldb * es; }
    __device__ __forceinline__ bool next(int i, Unit& u) const { u.e = 0; u.lt = 0; return tm.map(i, u.pm, u.pn); }
    __device__ __forceinline__ const char* a_ptr(const Unit& u) const { return A + (size_t)u.pm * astep; }
    __device__ __forceinline__ const char* b_ptr(const Unit& u) const { return Bt + (size_t)u.pn * bstep; }
};
struct SchedIn {
    static constexpr bool GATHER = false;
    TileMap tm; const char* A; const char* Bt;
    __device__ __forceinline__ bool next(int i, Unit& u) const { u.e = 0; u.lt = 0; return tm.map(i, u.pm, u.pn); }
    __device__ __forceinline__ const char* a_ptr(const Unit& u) const { return A + (size_t)u.pm * 256 * 1024; }
    __device__ __forceinline__ const char* b_ptr(const Unit& u) const { return Bt + (size_t)u.pn * 256 * 1024; }
};
struct SchedFour {
    static constexpr bool GATHER = false;
    const char* A; const char* Bt; int G, c;
    __device__ __forceinline__ bool next(int i, Unit& u) const { const int L = i * G + c; if (L >= 256) return false; u.pm = L >> 1; u.pn = L & 1; u.e = (L >> 4) & 1; u.lt = 0; return true; }
    __device__ __forceinline__ const char* a_ptr(const Unit& u) const { return A + (size_t)u.pm * 256 * 1024 * 2; }
    __device__ __forceinline__ const char* b_ptr(const Unit& u) const { return Bt + (size_t)(u.e * 512 + u.pn * 256) * 1024 * 2; }
};
struct SchedDFT {
    static constexpr bool GATHER = false;
    const char* DS; const char* Yt; int G, c;
    __device__ __forceinline__ bool next(int i, Unit& u) const {
        const int L = i * G + c; if (L >= 256) return false;
        const int Lx = ((L & 7) << 5) | (L >> 3);
        u.pm = Lx >> 5; u.lt = (Lx >> 4) & 1; u.e = (Lx >> 1) & 7; u.pn = Lx & 1; return true;
    }
    __device__ __forceinline__ const char* a_ptr(const Unit& u) const { return DS + ((size_t)u.pm * 256 * 4096 + (size_t)u.lt * 2048); }
    __device__ __forceinline__ const char* b_ptr(const Unit& u) const { return Yt + (((size_t)u.e * 512 + (size_t)u.pn * 256) * 4096 + (size_t)u.lt * 2048); }
};
struct SchedBranch {
    static constexpr bool GATHER = false;
    TileMap tm; const char* ws; const char* W;
    __device__ __forceinline__ bool next(int i, Unit& u) const { u.e = i % 3; u.lt = 0; return tm.map(i / 3, u.pm, u.pn); }
    __device__ __forceinline__ const char* a_ptr(const Unit& u) const { const size_t off = WS_ATTN + (size_t)u.e * (WS_FOUR - WS_ATTN) + (u.e == 2 ? (WS_PD - WS_ATTN - 2 * (WS_FOUR - WS_ATTN)) : (size_t)0); return ws + off + (size_t)u.pm * 256 * 512 * 2; }
    __device__ __forceinline__ const char* b_ptr(const Unit& u) const { return W + ((size_t)u.e * 1024 + (size_t)u.pn * 256) * 512 * 2; }
};
struct MoeTiles {
    const LAS int* t;
    __device__ __forceinline__ void locate(int pm, int& e, int& lt) const { int ee = 0;
#pragma unroll
        for (int j = 1; j < 8; ++j) ee += (pm >= t[j]) ? 1 : 0;
        ee = __builtin_amdgcn_readfirstlane(ee); e = ee; lt = pm - __builtin_amdgcn_readfirstlane(t[ee]); }
    __device__ __forceinline__ int count(int e) const { return __builtin_amdgcn_readfirstlane(t[16 + e]); }
    __device__ __forceinline__ int total() const { return __builtin_amdgcn_readfirstlane(t[8]); }
};
__device__ __forceinline__ void moe_tiles_setup(LAS int* t, const unsigned* gcnt, int tid) {
    if (tid == 0) { int s = 0;
        for (int e = 0; e < 8; ++e) { const int c = (int)__hip_atomic_load(gcnt + e, __ATOMIC_RELAXED, __HIP_MEMORY_SCOPE_AGENT); t[16 + e] = c; t[e] = s; s += (c + 255) >> 8; } t[8] = s; }
    __syncthreads();
}
template <int ES> struct SchedMoeUp {
    static constexpr bool GATHER = true;
    TileMap tm; MoeTiles mt; const char* H; const char* W13; const u32x2* rinfo;
    __device__ __forceinline__ bool next(int i, Unit& u) const { if (!tm.map(i, u.pm, u.pn)) return false; mt.locate(u.pm, u.e, u.lt); return true; }
    __device__ __forceinline__ const char* a_ptr(const Unit&) const { return H; }
    __device__ __forceinline__ const char* b_ptr(const Unit& u) const { return W13 + ((size_t)u.e * 7168 + (size_t)u.pn * 256) * 1024 * ES; }
    __device__ __forceinline__ void a_offs(const Unit& u, const int (&R)[2], const int (&C)[2], unsigned (&vo)[2][2]) const {
        const int cnt = mt.count(u.e);
#pragma unroll
        for (int h = 0; h < 2; ++h)
#pragma unroll
            for (int i = 0; i < 2; ++i) { const int slot = u.lt * 256 + h * 128 + R[i]; unsigned tok = 0u;
                if (slot < cnt) tok = rinfo[(size_t)u.e * 32768 + slot].x & 0x7fffffffu;
                vo[h][i] = tok * (unsigned)(1024 * ES) + (unsigned)C[i] * 2u; }
    }
};
template <int ES> struct SchedMoeDown {
    static constexpr bool GATHER = false;
    TileMap tm; MoeTiles mt; const char* ACT; const char* W2; int lim;
    __device__ __forceinline__ bool next(int i, Unit& u) const { if ((long)i * tm.G + tm.c >= lim) return false; if (!tm.map(i, u.pm, u.pn)) return false; mt.locate(u.pm, u.e, u.lt); return true; }
    __device__ __forceinline__ const char* a_ptr(const Unit& u) const { return ACT + (size_t)u.pm * 256 * 3584 * ES; }
    __device__ __forceinline__ const char* b_ptr(const Unit& u) const { return W2 + ((size_t)u.e * 1024 + (size_t)u.pn * 256) * 3584 * ES; }
};
template <int ES, int KS> struct SchedMoeDownTail {
    static constexpr bool GATHER = false; static constexpr int KSL = 3584 / KS;
    TileMap tm; MoeTiles mt; const char* ACT; const char* W2; int lim, ntail;
    __device__ __forceinline__ bool next(int i, Unit& u) const {
        const int upx = (tm.G >> 3) / KS, xcd = tm.c & 7, idx = tm.c >> 3; if (idx >= upx * KS) return false;
        const int ti = (i * 8 + xcd) * upx + idx / KS, ks = idx % KS; if (ti >= ntail) return false;
        tm.map_L(lim + ti, u.pm, u.pn); mt.locate(u.pm, u.e, u.lt); u.lt |= (ks << 8) | (ti << 12); return true; }
    __device__ __forceinline__ const char* a_ptr(const Unit& u) const { return ACT + ((size_t)u.pm * 256 * 3584 + (size_t)(((u.lt >> 8) & 15) * KSL)) * ES; }
    __device__ __forceinline__ const char* b_ptr(const Unit& u) const { return W2 + (((size_t)u.e * 1024 + (size_t)u.pn * 256) * 3584 + (size_t)(((u.lt >> 8) & 15) * KSL)) * ES; }
};

struct EpiIn {
    static constexpr bool PERM = true; static constexpr int NST = 0;
    __device__ __forceinline__ bool keep(const Unit&) const { return false; }
    bf16_t *QKV, *UP, *GATES; const float* qg; const float* kg; LAS float* P;
    const float* SH; const float* SW;
    __device__ __forceinline__ void operator()(f32x4 (&acc)[2][2][4][2], const Unit& u, int wr, int wc, int fr_in, int fq_in) const {
        int fr = fr_in, fq = fq_in; asm volatile("" : "+v"(fr), "+v"(fq));
        { const float* swp = SW + u.pn * 256 + wc * 32 + 8 * fq; const float* shp = SH + u.pm * BM + wr * 64 + fr;
          const float vsc = (u.pn >= 12 && u.pn < 18) ? 8.0f : 1.0f;
          const float gsc = u.pn >= 20 ? -1.4426950408889634f : 1.0f;
#pragma unroll
          for (int bj = 0; bj < 2; ++bj) { const f32x4 sw0 = *(const f32x4*)(swp + bj * HALF) * gsc, sw1 = *(const f32x4*)(swp + bj * HALF + 4) * gsc;
#pragma unroll
              for (int ai = 0; ai < 2; ++ai)
#pragma unroll
                  for (int m = 0; m < 4; ++m) { const float sa = shp[ai * HALF + m * 16] * vsc;
                      const i32x4 q0 = __builtin_bit_cast(i32x4, acc[ai][bj][m][0]), q1 = __builtin_bit_cast(i32x4, acc[ai][bj][m][1]);
                      acc[ai][bj][m][0] = (f32x4){(float)q0[0], (float)q0[1], (float)q0[2], (float)q0[3]} * sw0 * sa;
                      acc[ai][bj][m][1] = (f32x4){(float)q1[0], (float)q1[1], (float)q1[2], (float)q1[3]} * sw1 * sa; }
              asm volatile("" ::: "memory"); } }
        bf16_t* base; int ldc, colt; bool sg = false;
        if (u.pn < 18) { base = QKV; ldc = 4608; colt = u.pn * 256; }
        else if (u.pn < 20) { base = UP; ldc = 512; colt = (u.pn - 18) * 256; }
        else { base = GATES; ldc = 3072; colt = (u.pn - 20) * 256; sg = true; }
        if (u.pn < 12) {
#pragma unroll
            for (int ai = 0; ai < 2; ++ai)
#pragma unroll
                for (int m = 0; m < 4; ++m)
#pragma unroll
                    for (int bj = 0; bj < 2; ++bj) { const f32x4 a = acc[ai][bj][m][0], b = acc[ai][bj][m][1];
                        float ss = (a[0] * a[0] + a[1] * a[1]) + (a[2] * a[2] + a[3] * a[3]) + (b[0] * b[0] + b[1] * b[1]) + (b[2] * b[2] + b[3] * b[3]);
                        ss += __shfl_xor(ss, 16); ss += __shfl_xor(ss, 32);
                        if (fq == 0) P[((ai * HALF + wr * 64 + m * 16 + fr) * 2 + bj) * 4 + wc] = ss; }
            asm volatile("s_waitcnt lgkmcnt(0)" ::: "memory"); __builtin_amdgcn_s_barrier(); asm volatile("" ::: "memory");
            const float* gn = (u.pn < 6 ? qg : kg) + wc * 32 + 8 * fq; const float qs = u.pn < 6 ? 0.08838834764831845f * 64.0f : 8.0f;
            const f32x4 g0 = *(const f32x4*)gn * qs, g1 = *(const f32x4*)(gn + 4) * qs;
#pragma unroll
            for (int ai = 0; ai < 2; ++ai)
#pragma unroll
                for (int m = 0; m < 4; ++m)
#pragma unroll
                    for (int bj = 0; bj < 2; ++bj) { const f32x4 p = *(const LAS f32x4*)(P + ((ai * HALF + wr * 64 + m * 16 + fr) * 2 + bj) * 4);
                        const float rstd = __builtin_amdgcn_rsqf(((p[0] + p[1]) + (p[2] + p[3])) * (1.0f / 128.0f) + RMS_EPS);
                        acc[ai][bj][m][0] *= g0 * rstd; acc[ai][bj][m][1] *= g1 * rstd; }
        }
        const int row0 = u.pm * BM + wr * 64 + fr, col0 = colt + wc * 32 + 8 * fq;
#pragma unroll
        for (int ai = 0; ai < 2; ++ai)
#pragma unroll
            for (int m = 0; m < 4; ++m) { bf16_t* rowp = base + (size_t)(row0 + ai * HALF + m * 16) * ldc + col0;
#pragma unroll
                for (int bj = 0; bj < 2; ++bj) { f32x4 v0 = acc[ai][bj][m][0], v1 = acc[ai][bj][m][1];
                    if (sg) {
                        float y[8];
#pragma unroll
                        for (int j = 0; j < 4; ++j) {
                            y[j] = __builtin_amdgcn_rcpf(__builtin_amdgcn_fmed3f(__builtin_fmaf(__builtin_amdgcn_exp2f(v0[j]), 1.0f / 255.0f, 1.0f / 255.0f), 0.0f, 1.0f)) + 8388608.0f;
                            y[4 + j] = __builtin_amdgcn_rcpf(__builtin_amdgcn_fmed3f(__builtin_fmaf(__builtin_amdgcn_exp2f(v1[j]), 1.0f / 255.0f, 1.0f / 255.0f), 0.0f, 1.0f)) + 8388608.0f; }
                        u32x2 w;
                        w.x = __builtin_amdgcn_perm(__float_as_uint(y[1]), __float_as_uint(y[0]), 0x0c0c0400u) | __builtin_amdgcn_perm(__float_as_uint(y[3]), __float_as_uint(y[2]), 0x04000c0cu);
                        w.y = __builtin_amdgcn_perm(__float_as_uint(y[5]), __float_as_uint(y[4]), 0x0c0c0400u) | __builtin_amdgcn_perm(__float_as_uint(y[7]), __float_as_uint(y[6]), 0x04000c0cu);
                        *(u32x2*)((unsigned char*)base + ((size_t)(u.pm * 12 + (u.pn - 20)) << 16) + (size_t)((((((wr * 4 + wc) * 2 + ai) * 4 + m) * 2 + bj) << 9) + ((fq * 16 + fr) << 3))) = w;
                    } else if (u.pn < 12) { u32x2 w; w.x = pk8x4_nc(v0[0], v0[1], v0[2], v0[3]); w.y = pk8x4_nc(v1[0], v1[1], v1[2], v1[3]);
                        *(u32x2*)((unsigned char*)base + (size_t)(row0 + ai * HALF + m * 16) * ldc + col0 + bj * HALF) = w;
                    } else if (u.pn < 18) { u32x2 w; w.x = pk8x4(v0[0], v0[1], v0[2], v0[3]); w.y = pk8x4(v1[0], v1[1], v1[2], v1[3]);
                        *(u32x2*)((unsigned char*)base + (size_t)(row0 + ai * HALF + m * 16) * ldc + col0 + bj * HALF) = w;
                    } else {
                    u32x4 w; w.x = pk2(v0[0], v0[1]); w.y = pk2(v0[2], v0[3]); w.z = pk2(v1[0], v1[1]); w.w = pk2(v1[2], v1[3]);
                    *(u32x4*)(rowp + bj * HALF) = w; } } }
    }
};
struct EpiYtf {
    static constexpr bool PERM = false; static constexpr int NST = 0;
    __device__ __forceinline__ bool keep(const Unit&) const { return false; }
    unsigned char* Ytf;
    __device__ __forceinline__ void operator()(f32x4 (&acc)[2][2][4][2], const Unit& u, int wr, int wc, int fr, int fq) const {
        const int rowt = u.pm * BM, b = rowt >> 12, kbase = rowt & 4095;
        const int c0 = u.pn * 256 + wc * 32 + fr;
#pragma unroll
        for (int bj = 0; bj < 2; ++bj)
#pragma unroll
            for (int n = 0; n < 2; ++n) { unsigned char* cp = Ytf + ((size_t)b * 512 + c0 + bj * HALF + n * 16) * 4096 + kbase + wr * 64 + 4 * fq;
#pragma unroll
                for (int ai = 0; ai < 2; ++ai)
#pragma unroll
                    for (int m = 0; m < 4; ++m) { const f32x4 v = acc[ai][bj][m][n] * DFT_SY; *(unsigned*)(cp + ai * HALF + m * 16) = pk8x4(v[0], v[1], v[2], v[3]); } }
    }
};
struct EpiDFT {
    static constexpr bool PERM = true; static constexpr int NST = 16;
    __device__ __forceinline__ bool keep(const Unit&) const { return false; }
    bf16_t* P;
    __device__ __forceinline__ void operator()(f32x4 (&acc)[2][2][4][2], const Unit& u, int wr, int wc, int fr, int fq) const {
        const int row0 = (u.lt * 8 + u.e) * 2048 + u.pm * BM + wr * 64 + fr, col0 = u.pn * 256 + wc * 32 + 8 * fq;
#pragma unroll
        for (int ai = 0; ai < 2; ++ai)
#pragma unroll
            for (int m = 0; m < 4; ++m) { bf16_t* rowp = P + (size_t)(row0 + ai * HALF + m * 16) * 512 + col0;
#pragma unroll
                for (int bj = 0; bj < 2; ++bj) stx8(rowp + bj * HALF, 0, acc[ai][bj][m][0] * (1.0f / (DFT_SA * DFT_SY)), acc[ai][bj][m][1] * (1.0f / (DFT_SA * DFT_SY))); }
    }
};
__device__ __forceinline__ f32x4 ub4(unsigned w) { return (f32x4){(float)(w & 0xffu), (float)((w >> 8) & 0xffu), (float)((w >> 16) & 0xffu), (float)(w >> 24)}; }
struct EpiBranch {
    static constexpr bool PERM = true; static constexpr int NST = 16;
    const unsigned char* GATES; bf16_t* MERGED;
    __device__ __forceinline__ bool keep(const Unit& u) const { return u.e < 2; }
    __device__ __forceinline__ void operator()(f32x4 (&acc)[2][2][4][2], const Unit& u, int wr, int wc, int fr, int fq) const {
        const int row0 = u.pm * BM + wr * 64 + fr, col0 = u.pn * BM + wc * 32 + 8 * fq;
#pragma unroll
        for (int ai = 0; ai < 2; ++ai)
#pragma unroll
            for (int m = 0; m < 4; ++m) { const size_t row = (size_t)(row0 + ai * HALF + m * 16);
                const unsigned char* gp = GATES + ((size_t)(u.pm * 12 + u.e * 4 + u.pn) << 16) + (size_t)(((((wr * 4 + wc) * 2 + ai) * 4 + m) << 10) + ((fq * 16 + fr) << 3));
                if (u.e < 2) {
#pragma unroll
                    for (int bj = 0; bj < 2; ++bj) { const u32x2 ga = *(const u32x2*)(gp + bj * 512), gb = *(const u32x2*)(gp + 4 * 65536 + bj * 512);
                        const f32x4 a0 = ub4(ga.x), a1 = ub4(ga.y), b0 = ub4(gb.x), b1 = ub4(gb.y);
                        f32x4 r0, r1;
#pragma unroll
                        for (int j = 0; j < 4; ++j) { r0[j] = a0[j] * __builtin_amdgcn_rcpf(b0[j]); r1[j] = a1[j] * __builtin_amdgcn_rcpf(b1[j]); }
                        acc[ai][bj][m][0] *= r0; acc[ai][bj][m][1] *= r1; }
                } else { bf16_t* mp = MERGED + row * 1024 + col0;
#pragma unroll
                    for (int bj = 0; bj < 2; ++bj) { const u32x2 ga = *(const u32x2*)(gp + bj * 512);
                        const f32x4 v0 = acc[ai][bj][m][0] * ub4(ga.x) * (1.0f / 255.0f), v1 = acc[ai][bj][m][1] * ub4(ga.y) * (1.0f / 255.0f);
                        u32x4 w; w.x = pk2(v0[0], v0[1]); w.y = pk2(v0[2], v0[3]); w.z = pk2(v1[0], v1[1]); w.w = pk2(v1[2], v1[3]);
                        *(u32x4*)(mp + bj * HALF) = w; } }
                asm volatile("" ::: "memory"); }
    }
};
template <bool BASE_BF> struct EpiRes {
    static constexpr bool PERM = true; static constexpr int NST = 32;
    __device__ __forceinline__ bool keep(const Unit&) const { return false; }
    const void* base; bf16_t* out; float sc;
    __device__ __forceinline__ void operator()(f32x4 (&acc)[2][2][4][2], const Unit& u, int wr, int wc, int fr, int fq) const {
        const int row0 = u.pm * BM + wr * 64 + fr, col0 = u.pn * BM + wc * 32 + 8 * fq;
#pragma unroll
        for (int ai = 0; ai < 2; ++ai)
#pragma unroll
            for (int m = 0; m < 4; ++m) { const size_t off = (size_t)(row0 + ai * HALF + m * 16) * 1024 + col0;
#pragma unroll
                for (int bj = 0; bj < 2; ++bj) { const size_t i8 = (off + bj * HALF) >> 3; f32x4 b0, b1; ldx8<BASE_BF>(base, i8, b0, b1); stx8(out, i8, b0 + acc[ai][bj][m][0] * sc, b1 + acc[ai][bj][m][1] * sc); } }
    }
};
template <bool F8, bool IN8 = false> struct EpiSwiglu {
    static constexpr bool PERM = true; static constexpr int NST = IN8 ? 0 : 8;
    __device__ __forceinline__ bool keep(const Unit&) const { return false; }
    void* ACT; int ldc; float sin, sout; const float* SH; const float* SW;
    __device__ __forceinline__ void operator()(f32x4 (&acc)[2][2][4][2], const Unit& u, int wr, int wc, int fr_in, int fq_in) const {
        int fr = fr_in, fq = fq_in; asm volatile("" : "+v"(fr), "+v"(fq));
        const int row0 = u.pm * BM + wr * 64 + fr, col0 = u.pn * 128 + wc * 32 + 8 * fq;
        f32x4 sw[2][2];
        if constexpr (IN8) { const float* swp = SW + u.pn * 256 + wc * 32 + 8 * fq;
#pragma unroll
            for (int bj = 0; bj < 2; ++bj) { sw[bj][0] = *(const f32x4*)(swp + bj * HALF); sw[bj][1] = *(const f32x4*)(swp + bj * HALF + 4); }
            sw[1][0] *= sw[0][0]; sw[1][1] *= sw[0][1]; sw[0][0] *= -1.4426950408889634f; sw[0][1] *= -1.4426950408889634f; }
#pragma unroll
        for (int ai = 0; ai < 2; ++ai)
#pragma unroll
            for (int m = 0; m < 4; ++m) { const size_t eo = (size_t)(row0 + ai * HALF + m * 16) * ldc + col0;
                float o[8]; float sa = 1.0f, sa2 = 1.0f; if constexpr (IN8) { sa = SH[row0 + ai * HALF + m * 16]; sa2 = sa * sa * sout; }
#pragma unroll
                for (int n = 0; n < 2; ++n)
#pragma unroll
                    for (int j = 0; j < 4; ++j) {
                        if constexpr (IN8) { const float f0 = (float)__builtin_bit_cast(i32x4, acc[ai][0][m][n])[j], f1 = (float)__builtin_bit_cast(i32x4, acc[ai][1][m][n])[j];
                            o[n * 4 + j] = (f0 * f1) * sw[1][n][j] * sa2 * __builtin_amdgcn_rcpf(1.0f + __builtin_amdgcn_exp2f(f0 * sw[0][n][j] * sa)); }
                        else { const float a0 = acc[ai][0][m][n][j], b0 = acc[ai][1][m][n][j];
                            o[n * 4 + j] = (a0 * b0) * (sin * sin * sout) * __builtin_amdgcn_rcpf(1.0f + __builtin_amdgcn_exp2f(a0 * (sin * -1.4426950408889634f))); } }
                if constexpr (F8) { u32x2 w; w.x = pk8x4(o[0], o[1], o[2], o[3]); w.y = pk8x4(o[4], o[5], o[6], o[7]); *(u32x2*)((unsigned char*)ACT + eo) = w; }
                else { u32x4 w; w.x = pk2(o[0], o[1]); w.y = pk2(o[2], o[3]); w.z = pk2(o[4], o[5]); w.w = pk2(o[6], o[7]); *(u32x4*)((bf16_t*)ACT + eo) = w; } }
    }
};
struct EpiMoeDown {
    static constexpr bool PERM = true; static constexpr int NST = 0;
    __device__ __forceinline__ bool keep(const Unit&) const { return false; }
    bf16_t* x; bf16_t* y1; const u32x2* rinfo; MoeTiles mt; float sc; unsigned rmask = 0xffu;
    __device__ __forceinline__ void operator()(f32x4 (&acc)[2][2][4][2], const Unit& u, int wr, int wc, int fr, int fq) const {
        const int cnt = mt.count(u.e);
        const int col0 = u.pn * BM + wc * 32 + 8 * fq;
#pragma unroll
        for (int ai = 0; ai < 2; ++ai)
#pragma unroll
            for (int m = 0; m < 4; ++m) { const int slot = u.lt * 256 + ai * HALF + wr * 64 + m * 16 + fr;
                if (((rmask >> (ai * 4 + m)) & 1u) && slot < cnt) { const u32x2 ri = rinfo[(size_t)u.e * 32768 + slot]; const unsigned tok = ri.x & 0x7fffffffu; const bool k1 = (ri.x >> 31) != 0u; const float gt = __uint_as_float(ri.y) * sc;
                    const size_t off = (size_t)tok * 1024 + col0;
#pragma unroll
                    for (int bj = 0; bj < 2; ++bj) { const f32x4 v0 = acc[ai][bj][m][0] * gt, v1 = acc[ai][bj][m][1] * gt; const size_t i8 = (off + bj * HALF) >> 3;
                            if (k1) stx8(y1, i8, v0, v1);
                            else { f32x4 b0, b1; ldx8<true>(x, i8, b0, b1); stx8(x, i8, b0 + v0, b1 + v1); } } } }
    }
};
template <int KS> struct EpiMoeDownTail {
    static constexpr bool PERM = true; static constexpr int NST = 0;
    __device__ __forceinline__ bool keep(const Unit&) const { return false; }
    EpiMoeDown inner; float* slab; unsigned* cnt; LAS int* flag;
    __device__ __forceinline__ void operator()(f32x4 (&acc)[2][2][4][2], const Unit& u, int wr, int wc, int fr, int fq) const {
        const int ks = (u.lt >> 8) & 15, ti = u.lt >> 12, wave = wr * 4 + wc, lane = fq * 16 + fr;
        const __amdgpu_buffer_rsrc_t rs = __builtin_amdgcn_make_buffer_rsrc((void*)slab, (short)0, (int)(MOE_TAIL_MAX * KS * 262144), 0x00020000);
        { const unsigned wo = ((unsigned)(ti * KS + ks) * 8u + (unsigned)wave) * 32768u + (unsigned)lane * 16u;
#pragma unroll
          for (int j = 0; j < 32; ++j) __builtin_amdgcn_raw_buffer_store_b128(__builtin_bit_cast(u32x4, acc[j >> 4][(j >> 3) & 1][(j >> 1) & 3][j & 1]), rs, wo + (unsigned)j * 1024u, 0, 16); }
        asm volatile("s_waitcnt vmcnt(0)" ::: "memory");
        __syncthreads();
        if (threadIdx.x == 0) {
            (void)__hip_atomic_fetch_add(cnt + ti, 1u, __ATOMIC_RELAXED, __HIP_MEMORY_SCOPE_AGENT);
            unsigned sp = 0u;
            while (__hip_atomic_load(cnt + ti, __ATOMIC_RELAXED, __HIP_MEMORY_SCOPE_AGENT) < (unsigned)KS) { __builtin_amdgcn_s_sleep(1); if (++sp > (1u << 22)) break; }
            __builtin_amdgcn_fence(__ATOMIC_ACQUIRE, "agent"); asm volatile("s_waitcnt vmcnt(0)" ::: "memory"); }
        __syncthreads();
        const unsigned ro = ((unsigned)(ti * KS) * 8u + (unsigned)wave) * 32768u + (unsigned)lane * 16u;
        Unit v = u; v.lt = u.lt & 255;
#pragma unroll
        for (int rg = 0; rg < 8; ++rg) { if (rg % KS != ks) continue;
            const int ai = rg >> 2, m = rg & 3; f32x4 sm[4];
#pragma unroll
            for (int q = 0; q < 4; ++q) { const unsigned jo = (unsigned)(ai * 16 + (q >> 1) * 8 + m * 2 + (q & 1)) * 1024u;
                sm[q] = __builtin_bit_cast(f32x4, __builtin_amdgcn_raw_buffer_load_b128(rs, ro + jo, 0, 16));
#pragma unroll
                for (int k2 = 1; k2 < KS; ++k2) sm[q] += __builtin_bit_cast(f32x4, __builtin_amdgcn_raw_buffer_load_b128(rs, ro + (unsigned)k2 * 262144u + jo, 0, 16)); }
            asm volatile("" : "+v"(sm[0]), "+v"(sm[1]), "+v"(sm[2]), "+v"(sm[3]) :: "memory");
            f32x4 a2[2][2][4][2]; a2[ai][0][m][0] = sm[0]; a2[ai][0][m][1] = sm[1]; a2[ai][1][m][0] = sm[2]; a2[ai][1][m][1] = sm[3];
            EpiMoeDown in2 = inner; in2.rmask = 1u << rg; in2(a2, v, wr, wc, fr, fq); }
    }
};
}

struct Args {
    const float* in[21];
    float* out; unsigned char* ws;
    int ph_lo, ph_hi;
};
typedef const __attribute__((address_space(4))) Args CArgs;
__device__ __forceinline__ Args load_args(CArgs* ap) { Args a;
#pragma unroll
    for (int i = 0; i < 21; ++i) a.in[i] = ap->in[i];
    a.out = ap->out; a.ws = ap->ws; a.ph_lo = ap->ph_lo; a.ph_hi = ap->ph_hi; return a; }
enum { I_X = 0, I_NMG, I_WIN, I_QG, I_KG, I_RELB, I_POOLW, I_POOLS, I_WBA, I_WBF, I_WBP, I_WOUT, I_NFG, I_W1, I_W3, I_W2, I_RW, I_RB, I_MW1, I_MW3, I_MW2 };

__device__ __forceinline__ void cvt_item(const float* src, int ldsrc, int k0, int c0, bf16_t* dst, int ldd, int r0, LAS float* scr, int lane) {
#pragma unroll 8
    for (int i = 0; i < 32; ++i) { const int kk = 2 * i + (lane >> 5); scr[kk * 33 + (lane & 31)] = src[(size_t)(k0 + kk) * ldsrc + c0 + (lane & 31)]; }
    LDS_WAIT(); asm volatile("" ::: "memory");
    const int c = lane & 7;
#pragma unroll
    for (int j = 0; j < 4; ++j) { const int n = (lane >> 3) + 8 * j; const LAS float* s = scr + (8 * c) * 33 + n;
        u32x4 o; o.x = pk2(s[0 * 33], s[1 * 33]); o.y = pk2(s[2 * 33], s[3 * 33]); o.z = pk2(s[4 * 33], s[5 * 33]); o.w = pk2(s[6 * 33], s[7 * 33]);
        *(u32x4*)(dst + (size_t)(r0 + n) * ldd + k0 + 8 * c) = o; }
    LDS_WAIT(); asm volatile("" ::: "memory");
}
__device__ __forceinline__ void cvt_plain(const float* src, int ldsrc, int K, bf16_t* dst, int row0, int nrows, int coff, LAS float* scr, int gw, int NGW, int lane) {
    const int nblk = nrows / 32, items = (K / 64) * nblk;
    for (int it = gw; it < items; it += NGW) { const int kb = it / nblk, nb = it % nblk; const int r0 = row0 + nb * 32; cvt_item(src, ldsrc, kb * 64, r0 + coff, dst, K, r0, scr, lane); }
}
__device__ __forceinline__ void cvt_w13(const float* w1, const float* w3, int ncol, int nmat, bf16_t* dst, LAS float* scr, int gw, int NGW, int lane) {
    const int nblk = (2 * ncol) / 32, per = 16 * nblk, items = per * nmat;
    for (int it = gw; it < items; it += NGW) { const int e = it / per, r = it % per, kb = r / nblk, nb = r % nblk; const int r0 = nb * 32; const int s = (r0 >> 7) & 1, c0 = (r0 >> 8) * 128 + (r0 & 127);
        cvt_item((s ? w3 : w1) + (size_t)e * 1024 * ncol, ncol, kb * 64, c0, dst + (size_t)e * 2 * ncol * 1024, 1024, r0, scr, lane); }
}

__device__ __forceinline__ void cvt_item8(const float* src, int ldsrc, int k0, int c0, unsigned char* dst, int ldd, int r0, float sc, LAS float* scr, int lane) {
#pragma unroll 8
    for (int i = 0; i < 32; ++i) { const int kk = 2 * i + (lane >> 5); scr[kk * 33 + (lane & 31)] = src[(size_t)(k0 + kk) * ldsrc + c0 + (lane & 31)]; }
    LDS_WAIT(); asm volatile("" ::: "memory");
    const int c = lane & 7;
#pragma unroll
    for (int j = 0; j < 4; ++j) { const int n = (lane >> 3) + 8 * j; const LAS float* s = scr + (8 * c) * 33 + n;
        u32x2 o; o.x = pk8x4(s[0 * 33] * sc, s[1 * 33] * sc, s[2 * 33] * sc, s[3 * 33] * sc); o.y = pk8x4(s[4 * 33] * sc, s[5 * 33] * sc, s[6 * 33] * sc, s[7 * 33] * sc);
        *(u32x2*)(dst + (size_t)(r0 + n) * ldd + k0 + 8 * c) = o; }
    LDS_WAIT(); asm volatile("" ::: "memory");
}
__device__ __forceinline__ void cvt_plain8(const float* src, int ldsrc, int K, unsigned char* dst, int nrows, float sc, LAS float* scr, int gw, int NGW, int lane) {
    const int nblk = nrows / 32, items = (K / 64) * nblk;
    for (int it = gw; it < items; it += NGW) { const int kb = it / nblk, nb = it % nblk; cvt_item8(src, ldsrc, kb * 64, nb * 32, dst, K, nb * 32, sc, scr, lane); }
}
__device__ __forceinline__ void cvt_w13_8(const float* w1, const float* w3, int ncol, int nmat, unsigned char* dst, float sc, LAS float* scr, int gw, int NGW, int lane) {
    const int nblk = (2 * ncol) / 32, per = 16 * nblk, items = per * nmat;
    for (int it = gw; it < items; it += NGW) { const int e = it / per, r = it % per, kb = r / nblk, nb = r % nblk; const int r0 = nb * 32; const int s = (r0 >> 7) & 1, c0 = (r0 >> 8) * 128 + (r0 & 127);
        cvt_item8((s ? w3 : w1) + (size_t)e * 1024 * ncol, ncol, kb * 64, c0, dst + (size_t)e * 2 * ncol * 1024, 1024, r0, sc, scr, lane); }
}

__device__ __forceinline__ void w8_strip(const float* src, int ld, signed char* W8r0, float* SWr0, LAS float* smax, int wave, int lane) {
    const int n = lane & 31, kh = lane >> 5;
    const float* p = src + (size_t)(128 * wave + kh) * ld + n;
    float v[64];
#pragma unroll
    for (int i = 0; i < 64; ++i) v[i] = p[(size_t)(2 * i) * ld];
    float mx = 0.f;
#pragma unroll
    for (int i = 0; i < 64; ++i) mx = fmaxf(mx, fabsf(v[i]));
    mx = fmaxf(mx, __shfl_xor(mx, 32));
    if (lane < 32) smax[wave * 32 + n] = mx;
    __syncthreads();
    mx = smax[n];
#pragma unroll
    for (int w = 1; w < 8; ++w) mx = fmaxf(mx, smax[w * 32 + n]);
    mx = fmaxf(mx, 1e-30f);
    __syncthreads();
    if (wave == 0 && lane < 32) SWr0[n] = mx * (1.0f / 127.0f);
    const float inv = 127.0f / mx;
#pragma unroll
    for (int u = 0; u < 4; ++u) { unsigned wd[2][4];
#pragma unroll
        for (int tt = 0; tt < 2; ++tt)
#pragma unroll
            for (int e = 0; e < 4; ++e) { const int i0 = 8 * (2 * u + tt) + 2 * e;
                const int a0 = (int)rintf(v[i0] * inv), a1 = (int)rintf(v[i0 + 1] * inv); const int b0 = __shfl_xor(a0, 32), b1 = __shfl_xor(a1, 32);
                const int ev0 = kh ? b0 : a0, od0 = kh ? a0 : b0, ev1 = kh ? b1 : a1, od1 = kh ? a1 : b1;
                wd[tt][e] = ((unsigned)ev0 & 0xffu) | (((unsigned)od0 & 0xffu) << 8) | (((unsigned)ev1 & 0xffu) << 16) | ((unsigned)od1 << 24); }
        u32x4 o; o.x = kh ? wd[1][0] : wd[0][0]; o.y = kh ? wd[1][1] : wd[0][1]; o.z = kh ? wd[1][2] : wd[0][2]; o.w = kh ? wd[1][3] : wd[0][3];
        *(u32x4*)(W8r0 + (size_t)n * 1024 + 128 * wave + 16 * (2 * u + kh)) = o; }
}
__device__ __forceinline__ void w8_strips(const Args& a, unsigned char* ws, LAS unsigned char* lds, int vcu, int G, int wave, int lane) {
    LAS float* smax = (LAS float*)(lds + 131072);
    for (int sidx = vcu; sidx < DEPTH * 256 + 2 * 176; sidx += G) {
        if (sidx < DEPTH * 256) { const int l = sidx >> 8, st = sidx & 255, r0 = st * 32, c0 = r0 < 4608 ? r0 : r0 + 512;
            w8_strip(a.in[I_WIN] + (size_t)l * 1024 * SRC_IN + c0, SRC_IN, (signed char*)(ws + WS_WIN + (size_t)l * WIN_SLOT) + (size_t)r0 * 1024, (float*)(ws + WS_WIN + (size_t)l * WIN_SLOT + WIN_SW) + r0, smax, wave, lane); }
        else { const int q = sidx - DEPTH * 256, j = q >= 176 ? 1 : 0, st = q - j * 176, r0 = st * 32, sel = (r0 >> 7) & 1, c0 = (r0 >> 8) * 128 + (r0 & 127);
            if ((DENSE_UP8_MASK >> j) & 1) w8_strip((sel ? a.in[I_W3] : a.in[I_W1]) + (size_t)j * 1024 * FF + c0, FF, (signed char*)(ws + WS_W13 + (size_t)j * W13_SLOT) + (size_t)r0 * 1024, (float*)(ws + WS_W13 + (size_t)j * W13_SLOT + W13_SW) + r0, smax, wave, lane); }
    }
}

__device__ __forceinline__ void prologue_phase(const Args& a, LAS unsigned char* lds, int vcu, int G, int tid, int wave, int lane) {
    unsigned char* ws = a.ws;
    LAS float* scr = (LAS float*)(lds + wave * 16384);
    const int gw = vcu * NWAVES + wave, NGW = G * NWAVES;
    w8_strips(a, ws, lds, vcu, G, wave, lane);
    for (int it = gw; it < 4096 + 2 * 4224; it += NGW) {
        if (it < 4096) { const int l = it >> 10, r = it & 1023;
            if (r < 512) { const int q = r & 255; const float* src = (r < 256 ? a.in[I_WBA] : a.in[I_WBF]) + (size_t)l * 512 * 1024; bf16_t* dst = (bf16_t*)(ws + WS_WB) + ((size_t)l * 3 + (r >> 8)) * 1024 * 512;
                cvt_item(src, 1024, (q >> 5) * 64, (q & 31) * 32, dst, 512, (q & 31) * 32, scr, lane); }
            else { const int q = r - 512; cvt_item(a.in[I_WOUT] + (size_t)l * 1024 * 1024, 1024, (q >> 5) * 64, (q & 31) * 32, (bf16_t*)(ws + WS_WO) + (size_t)l * 1024 * 1024, 1024, (q & 31) * 32, scr, lane); }
        } else { const int r = it - 4096, j = r >= 4224 ? 1 : 0, q = r - j * 4224; const bool f8j = ((DENSE_F8_MASK >> j) & 1) != 0;
            bf16_t* d13 = (bf16_t*)(ws + WS_W13) + (size_t)j * 2 * FF * 1024; bf16_t* d2 = (bf16_t*)(ws + WS_W2) + (size_t)j * 1024 * FF;
            if (q < 2816) { if ((DENSE_UP8_MASK >> j) & 1) continue;
                const int kb = q / 176, nb = q % 176, r0 = nb * 32, sel = (r0 >> 7) & 1, c0 = (r0 >> 8) * 128 + (r0 & 127);
                const float* src = (sel ? a.in[I_W3] : a.in[I_W1]) + (size_t)j * 1024 * FF;
                if (f8j) cvt_item8(src, FF, kb * 64, c0, (unsigned char*)d13, 1024, r0, F8_SW, scr, lane); else cvt_item(src, FF, kb * 64, c0, d13, 1024, r0, scr, lane); }
            else { const int q2 = q - 2816, kb = q2 >> 5, nb = q2 & 31; const float* src = a.in[I_W2] + (size_t)j * FF * 1024;
                if (f8j) cvt_item8(src, 1024, kb * 64, nb * 32, (unsigned char*)d2, FF, nb * 32, F8_SW, scr, lane); else cvt_item(src, 1024, kb * 64, nb * 32, d2, FF, nb * 32, scr, lane); } }
    }
    __syncthreads();
    {
        LAS float* tab = (LAS float*)lds;
        if (tid < 256) { const int j = tid & 127; const float ang = (float)j * (1.0f / 64.0f); tab[tid] = (tid < 128 ? cospif(ang) : sinpif(ang)) * 0.08838834764831845f; }
        __syncthreads();
        for (int pr_ = 0; pr_ < 1 + PROL_C; ++pr_)
        for (int it = gw; it < DEPTH * 4 * 64; it += NGW) {
            const int l = it >> 8, g = (it >> 6) & 3, kk0 = (it & 63) * 16;
            const float* p = a.in[I_WIN] + ((size_t)l * 1024 + kk0 + (lane & 15)) * SRC_IN + 4608 + g * 128 + (lane >> 4);
            float av[32];
#pragma unroll
            for (int s_ = 0; s_ < 32; ++s_) av[s_] = p[4 * s_];
            bf16_t* WINF = (bf16_t*)(ws + WS_WIN + (size_t)l * WIN_SLOT + WIN_F);
            for (int nt_ = 0; nt_ < 16; ++nt_) { const int cs = nt_ >> 3, k2 = (nt_ & 7) * 16 + (lane & 15);
                f32x4 acc = {0.f, 0.f, 0.f, 0.f}; int idx = (k2 * (lane >> 4)) & 127; const int step = (4 * k2) & 127;
#pragma unroll
                for (int s_ = 0; s_ < 32; ++s_) { const float bv = tab[cs * 128 + idx]; idx = (idx + step) & 127; acc = __builtin_amdgcn_mfma_f32_16x16x4f32(av[s_], bv, acc, 0, 0, 0); }
                u32x2 w; w.x = pk2(acc[0], acc[1]); w.y = pk2(acc[2], acc[3]);
                *(u32x2*)(WINF + (size_t)(cs * 512 + g * 128 + k2) * 1024 + kk0 + 4 * (lane >> 4)) = w; }
        }
        __syncthreads();
    }
    for (int it = vcu; it < DEPTH * 4 * 16; it += G) {
        const int l = it >> 6, g = (it >> 4) & 3, db = it & 15;
        const int d = db * 64 + lane;
        float reg[128];
        const float* wbp = a.in[I_WBP] + ((size_t)l * 512 + g * 128) * 1024 + d;
        const float* ps = a.in[I_POOLS] + l * 512 + g * 128;
#pragma unroll
        for (int j = 0; j < 128; ++j) reg[j] = wbp[(size_t)j * 1024] * ps[j];
        const float* pw = a.in[I_POOLW] + ((size_t)(l * 4 + g) * 128) * 128;
        bf16_t* WB2 = (bf16_t*)(ws + WS_WB) + ((size_t)l * 3 + 2) * 1024 * 512;
        for (int o = 0; o < 16; ++o) { const int c = wave * 16 + o; const float* pr = pw + c * 128; float s = 0.f;
#pragma unroll
            for (int j = 0; j < 128; ++j) { s += pr[j] * reg[j]; if ((j & 15) == 15) __builtin_amdgcn_sched_barrier(0); }
            WB2[(size_t)d * 512 + g * 128 + c] = (bf16_t)(pk2(s, 0.f) & 0xffffu); }
    }
    {
        __syncthreads();
        LAS float* ctab = (LAS float*)lds;
        for (int j = tid; j < 4096; j += NTHR) ctab[j] = cospif((float)j * (1.0f / 2048.0f)) * 0.015625f;
        __syncthreads();
        unsigned char* DS = (unsigned char*)(ws + WS_DS);
        const int nthr = G * NTHR;
        for (int id = vcu * NTHR + tid; id < 2048 * 512; id += nthr) {
            const int k1 = id >> 9, col = (id & 511) * 8, cs = col >> 11, pos = col & 2047;
            float v[8];
#pragma unroll
            for (int j = 0; j < 8; ++j) v[j] = ctab[(k1 * (pos + j) + (cs ? 1024 : 0)) & 4095] * DFT_SA;
            u32x2 w; w.x = pk8x4(v[0], v[1], v[2], v[3]); w.y = pk8x4(v[4], v[5], v[6], v[7]);
            *(u32x2*)(DS + (size_t)k1 * 4096 + col) = w;
        }
    }
}

__device__ __forceinline__ unsigned q8x4(f32x4 y, float inv) { const int a = (int)rintf(y.x * inv), b = (int)rintf(y.y * inv), c = (int)rintf(y.z * inv), d = (int)rintf(y.w * inv);
    return ((unsigned)a & 0xffu) | (((unsigned)b & 0xffu) << 8) | (((unsigned)c & 0xffu) << 16) | ((unsigned)d << 24); }
__device__ __forceinline__ float wave_max(float v) {
#pragma unroll
    for (int o = 1; o < 64; o <<= 1) v = fmaxf(v, __shfl_xor(v, o));
    return v;
}
template <int QM>
__device__ __forceinline__ void norm_phase(const bf16_t* xsrc, const float* gain, void* h, float* sh, int vcu, int G, int wave, int lane) {
    constexpr bool F8 = QM == 1;
    const int gw = vcu * NWAVES + wave, NGW = G * NWAVES;
    f32x4 gv[4];
#pragma unroll
    for (int j = 0; j < 4; ++j) gv[j] = ((const f32x4*)gain)[lane + 64 * j];
    for (int m = gw; m < NTOK; m += NGW) {
        f32x4 v[4]; float s = 0.f;
#pragma unroll
        for (int j = 0; j < 4; ++j) v[j] = ldx4<true>(xsrc + (size_t)m * DM, lane + 64 * j);
#pragma unroll
        for (int j = 0; j < 4; ++j) s += (v[j].x * v[j].x + v[j].y * v[j].y) + (v[j].z * v[j].z + v[j].w * v[j].w);
        const float rstd = 1.0f / sqrtf(wave_sum(s) * (1.f / DM) + RMS_EPS);
        u32x2* o8 = (u32x2*)((bf16_t*)h + (size_t)m * DM) + lane; unsigned* o4 = (unsigned*)((unsigned char*)h + (size_t)m * DM) + lane;
        if constexpr (QM == 2) { float mx = 0.f;
#pragma unroll
            for (int j = 0; j < 4; ++j) { v[j] = v[j] * rstd * gv[j];
#pragma unroll
                for (int e = 0; e < 4; ++e) mx = fmaxf(mx, fabsf(v[j][e])); }
            mx = fmaxf(wave_max(mx), 1e-30f); const float inv = 127.0f / mx;
            if (lane == 0) sh[m] = mx * (1.0f / 127.0f);
#pragma unroll
            for (int j = 0; j < 4; ++j) o4[64 * j] = q8x4(v[j], inv);
        } else {
#pragma unroll
        for (int j = 0; j < 4; ++j) { const f32x4 y = v[j] * rstd * gv[j];
            if constexpr (F8) o4[64 * j] = pk8x4(y.x, y.y, y.z, y.w); else { u32x2 w; w.x = pk2(y.x, y.y); w.y = pk2(y.z, y.w); o8[64 * j] = w; } } }
    }
}
template <bool BF>
__device__ __forceinline__ void norm1_pair_phase(const void* xsrc_, const bf16_t* yadd, bf16_t* xdst, const float* gain, signed char* h8, float* sh, bf16_t* hf, int vcu, int G, int wave, int lane) {
    const char* xsrc = (const char*)xsrc_; constexpr size_t RB = (size_t)DM * (BF ? 2 : 4);
    const int gw = vcu * NWAVES + wave, NGW = G * NWAVES;
    f32x4 gv[4];
#pragma unroll
    for (int j = 0; j < 4; ++j) gv[j] = ((const f32x4*)gain)[lane + 64 * j];
    for (int idx = gw; idx < NBATCH * 2049; idx += NGW) {
        const int b = idx / 2049, j = idx - b * 2049; const bool pair = j >= 1 && j <= 2047;
        const int mA = b * SEQ + j, mB = b * SEQ + (pair ? SEQ - j : j);
        f32x4 va[4], vb[4];
#pragma unroll
        for (int q = 0; q < 4; ++q) { va[q] = ldx4<BF>(xsrc + (size_t)mA * RB, lane + 64 * q); vb[q] = ldx4<BF>(xsrc + (size_t)mB * RB, lane + 64 * q); }
        if (yadd) {
#pragma unroll
            for (int q = 0; q < 4; ++q) { va[q] += ldx4<true>(yadd + (size_t)mA * DM, lane + 64 * q); vb[q] += ldx4<true>(yadd + (size_t)mB * DM, lane + 64 * q); } }
        if (xdst) {
#pragma unroll
            for (int q = 0; q < 4; ++q) { stx4(xdst + (size_t)mA * DM, lane + 64 * q, va[q]); if (pair) stx4(xdst + (size_t)mB * DM, lane + 64 * q, vb[q]); } }
        float sa = 0.f, sb = 0.f;
#pragma unroll
        for (int q = 0; q < 4; ++q) { sa += (va[q].x * va[q].x + va[q].y * va[q].y) + (va[q].z * va[q].z + va[q].w * va[q].w); sb += (vb[q].x * vb[q].x + vb[q].y * vb[q].y) + (vb[q].z * vb[q].z + vb[q].w * vb[q].w); }
        const float ra = 1.0f / sqrtf(wave_sum(sa) * (1.f / DM) + RMS_EPS), rb = 1.0f / sqrtf(wave_sum(sb) * (1.f / DM) + RMS_EPS);
        float ma = 0.f, mb = 0.f;
#pragma unroll
        for (int q = 0; q < 4; ++q) { va[q] = va[q] * ra * gv[q]; vb[q] = vb[q] * rb * gv[q];
#pragma unroll
            for (int e = 0; e < 4; ++e) { ma = fmaxf(ma, fabsf(va[q][e])); mb = fmaxf(mb, fabsf(vb[q][e])); } }
        ma = fmaxf(wave_max(ma), 1e-30f); mb = fmaxf(wave_max(mb), 1e-30f);
        const float ia = 127.0f / ma, ib = 127.0f / mb;
        unsigned* oa = (unsigned*)(h8 + (size_t)mA * DM) + lane; unsigned* ob = (unsigned*)(h8 + (size_t)mB * DM) + lane;
        u32x2* os = (u32x2*)(hf + ((size_t)(b * 2 + 0) * 2048 + j) * DM) + lane; u32x2* od = (u32x2*)(hf + ((size_t)(b * 2 + 1) * 2048 + j) * DM) + lane;
        if (lane == 0) { sh[mA] = ma * (1.0f / 127.0f); if (pair) sh[mB] = mb * (1.0f / 127.0f); }
#pragma unroll
        for (int q = 0; q < 4; ++q) { const f32x4 ya = va[q], yb = vb[q];
            oa[64 * q] = q8x4(ya, ia);
            if (pair) { ob[64 * q] = q8x4(yb, ib);
                const f32x4 ys = ya + yb, yd = ya - yb; u32x2 w; w.x = pk2(ys.x, ys.y); w.y = pk2(ys.z, ys.w); os[64 * q] = w; w.x = pk2(yd.x, yd.y); w.y = pk2(yd.z, yd.w); od[64 * q] = w; }
            else if (j == 0) { u32x2 w; w.x = pk2(ya.x, ya.y); w.y = pk2(ya.z, ya.w); os[64 * q] = w; od[64 * q] = (u32x2){0u, 0u}; } }
    }
}
__device__ __forceinline__ void t2048_phase(const signed char* h8, const float* sh, const bf16_t* wcos, float* T, int vcu, int G, int wave, int lane) {
    const int gw = vcu * NWAVES + wave, NGW = G * NWAVES;
    for (int idx = gw; idx < NBATCH * 512; idx += NGW) { const int b = idx >> 9, c = idx & 511; const size_t row = (size_t)b * SEQ + 2048;
        const u32x4 a = ((const u32x4*)(h8 + row * DM))[lane];
        const u32x4* wp = (const u32x4*)(wcos + (size_t)c * DM) + 2 * lane; const u32x4 w0 = wp[0], w1 = wp[1];
        const unsigned aw[4] = {a.x, a.y, a.z, a.w}; const unsigned ww[8] = {w0.x, w0.y, w0.z, w0.w, w1.x, w1.y, w1.z, w1.w};
        float s = 0.f;
#pragma unroll
        for (int e = 0; e < 4; ++e) { const int q0 = (int)(aw[e] << 24) >> 24, q1 = (int)(aw[e] << 16) >> 24, q2 = (int)(aw[e] << 8) >> 24, q3 = (int)aw[e] >> 24;
            s += (float)q0 * bf_lo(ww[2 * e]) + (float)q1 * bf_hi(ww[2 * e]) + (float)q2 * bf_lo(ww[2 * e + 1]) + (float)q3 * bf_hi(ww[2 * e + 1]); }
        s = wave_sum(s) * sh[row];
        if (lane == 0) T[idx] = s; }
}
__device__ __forceinline__ void add_phase(float* out, const bf16_t* x, const bf16_t* y, int vcu, int G, int tid) {
    const int nthr = G * NTHR;
    for (int id = vcu * NTHR + tid; id < NTOK * DM / 8; id += nthr) { const u32x4 a = ((const u32x4*)x)[id], b = ((const u32x4*)y)[id];
        ((f32x4*)out)[2 * id] = (f32x4){bf_lo(a.x) + bf_lo(b.x), bf_hi(a.x) + bf_hi(b.x), bf_lo(a.y) + bf_lo(b.y), bf_hi(a.y) + bf_hi(b.y)};
        ((f32x4*)out)[2 * id + 1] = (f32x4){bf_lo(a.z) + bf_lo(b.z), bf_hi(a.z) + bf_hi(b.z), bf_lo(a.w) + bf_lo(b.w), bf_hi(a.w) + bf_hi(b.w)}; }
}
template <bool F8>
__device__ __forceinline__ void norm_router_phase(const bf16_t* x, const float* gain, const float* rw, const float* rb, void* h, unsigned* gcnt, u32x2* rinfo, unsigned long long* gran, const unsigned epoch,
                                                  LAS unsigned char* lds, int vcu, int G, int tid, int wave, int lane) {
    LAS unsigned* lcnt = (LAS unsigned*)(lds + MISC_OFF + 64);
    LAS unsigned* lbase = lcnt + 8;
    LAS unsigned* sel = lcnt + 16;
    LAS unsigned* wcnt = (LAS unsigned*)(lds + MISC_OFF + 3456);
    f32x4 gv[4];
#pragma unroll
    for (int j = 0; j < 4; ++j) gv[j] = ((const f32x4*)gain)[lane + 64 * j];
    float rwv[16][8];
#pragma unroll
    for (int j = 0; j < 4; ++j)
#pragma unroll
        for (int q = 0; q < 4; ++q) { const int d = 4 * lane + 256 * j + q; const f32x4 a0 = *(const f32x4*)(rw + d * 8), a1 = *(const f32x4*)(rw + d * 8 + 4);
            rwv[j * 4 + q][0] = a0[0]; rwv[j * 4 + q][1] = a0[1]; rwv[j * 4 + q][2] = a0[2]; rwv[j * 4 + q][3] = a0[3]; rwv[j * 4 + q][4] = a1[0]; rwv[j * 4 + q][5] = a1[1]; rwv[j * 4 + q][6] = a1[2]; rwv[j * 4 + q][7] = a1[3]; }
    float rbv[8];
#pragma unroll
    for (int e = 0; e < 8; ++e) rbv[e] = rb[e];
    for (int ck = vcu; ck < NTOK / 128; ck += G) {
        if (tid < 8) lcnt[tid] = 0u;
        __syncthreads();
        for (int rr = 0; rr < 16; ++rr) {
            const int rl = wave * 16 + rr, m = ck * 128 + rl;
            f32x4 v[4]; float s = 0.f;
#pragma unroll
            for (int j = 0; j < 4; ++j) { v[j] = ldx4<true>(x + (size_t)m * DM, lane + 64 * j); s += (v[j].x * v[j].x + v[j].y * v[j].y) + (v[j].z * v[j].z + v[j].w * v[j].w); }
            const float rstd = 1.0f / sqrtf(wave_sum(s) * (1.f / DM) + RMS_EPS);
            u32x2* o8 = (u32x2*)((bf16_t*)h + (size_t)m * DM) + lane; unsigned* o4 = (unsigned*)((unsigned char*)h + (size_t)m * DM) + lane;
            float lg[8];
#pragma unroll
            for (int e = 0; e < 8; ++e) lg[e] = 0.f;
#pragma unroll
            for (int j = 0; j < 4; ++j) { const f32x4 y = v[j] * rstd * gv[j];
                if constexpr (F8) o4[64 * j] = pk8x4(y.x, y.y, y.z, y.w); else { u32x2 w; w.x = pk2(y.x, y.y); w.y = pk2(y.z, y.w); o8[64 * j] = w; }
#pragma unroll
                for (int e = 0; e < 8; ++e) lg[e] += y.x * rwv[j * 4 + 0][e] + y.y * rwv[j * 4 + 1][e] + y.z * rwv[j * 4 + 2][e] + y.w * rwv[j * 4 + 3][e]; }
#pragma unroll
            for (int e = 0; e < 8; ++e) lg[e] = wave_sum(lg[e]) + rbv[e];
            int e0 = 0; float v0 = lg[0];
#pragma unroll
            for (int e = 1; e < 8; ++e) if (lg[e] > v0) { v0 = lg[e]; e0 = e; }
            int e1 = -1; float v1 = -3.0e38f;
#pragma unroll
            for (int e = 0; e < 8; ++e) if (e != e0 && lg[e] > v1) { v1 = lg[e]; e1 = e; }
            const float g0 = 1.0f / (1.0f + __expf(v1 - v0)), g1 = 1.0f - g0;
            if (lane == 0) {
                sel[(rl * 2 + 0) * 3 + 0] = (unsigned)e0; sel[(rl * 2 + 0) * 3 + 2] = __float_as_uint(g0);
                sel[(rl * 2 + 1) * 3 + 0] = (unsigned)e1; sel[(rl * 2 + 1) * 3 + 2] = __float_as_uint(g1);
            }
        }
        __syncthreads();
        unsigned my_e = 0u, my_rank = 0u;
        if (tid < 256) { my_e = sel[tid * 3 + 0];
#pragma unroll
            for (int ee = 0; ee < 8; ++ee) { const unsigned long long mk = __ballot(my_e == (unsigned)ee);
                if (my_e == (unsigned)ee) my_rank = (unsigned)__popcll(mk & ((1ull << lane) - 1ull));
                if (lane == ee) wcnt[wave * 8 + ee] = (unsigned)__popcll(mk); } }
        __syncthreads();
        if (tid < 8) { const unsigned c = wcnt[tid] + wcnt[8 + tid] + wcnt[16 + tid] + wcnt[24 + tid]; lcnt[tid] = c; lbase[tid] = 0u;
            __hip_atomic_store(gran + (size_t)ck * 8 + tid, ((unsigned long long)epoch << 32) | c, __ATOMIC_RELAXED, __HIP_MEMORY_SCOPE_AGENT); }
        __syncthreads();
        { unsigned part = 0u;
          for (int idx = tid; idx < ck * 8; idx += NTHR) { unsigned long long g = 0ull; unsigned sp = 0u;
              do { g = __hip_atomic_load(gran + idx, __ATOMIC_RELAXED, __HIP_MEMORY_SCOPE_AGENT); if ((unsigned)(g >> 32) == epoch) break; __builtin_amdgcn_s_sleep(1); } while (++sp < (1u << 20));
              part += (unsigned)g; }
          if (part) __hip_atomic_fetch_add(lbase + (tid & 7), part, __ATOMIC_RELAXED, __HIP_MEMORY_SCOPE_WORKGROUP); }
        __syncthreads();
        if (tid < 256) { const int rl = tid >> 1, k = tid & 1; const unsigned gb = sel[tid * 3 + 2]; unsigned rk = my_rank;
            for (int w2 = 0; w2 < wave; ++w2) rk += wcnt[w2 * 8 + my_e];
            u32x2 ri; ri.x = (unsigned)(ck * 128 + rl) | ((unsigned)k << 31); ri.y = gb; rinfo[(size_t)my_e * 32768 + lbase[my_e] + rk] = ri; }
        if (ck == NTOK / 128 - 1 && tid < 8) __hip_atomic_store(gcnt + tid, lbase[tid] + lcnt[tid], __ATOMIC_RELAXED, __HIP_MEMORY_SCOPE_AGENT);
        __syncthreads();
    }
}

__device__ __forceinline__ int kv_off(int row, int ch) { return 256 * row + 16 * (ch ^ (((row & 3) << 2) | ((row >> 2) & 3))); }
__device__ __forceinline__ int t5_bucket(int rel) {
    const int n = rel < 0 ? -rel : rel; const int ret = rel > 0 ? 16 : 0;
    const int v = n < 8 ? n : 8 + (n >= 15) + (n >= 27) + (n >= 50) + (n >= 91) + (n >= 166) + (n >= 305) + (n >= 559);
    return ret + v;
}
template <int OFF> __device__ __forceinline__ long tr8_read_off(unsigned addr) { long r; asm volatile("ds_read_b64_tr_b8 %0, %1 offset:%2" : "=v"(r) : "v"(addr), "i"(OFF) : "memory"); return r; }
__device__ __forceinline__ void attn_unit_rows(int u, int wave, int lane, unsigned (&koffs)[4]) {
    const int b = u / 384, rem = u % 384, h = rem >> 5, c = rem & 31, sh = 2 * (h >> 2), L = SEQ >> sh, cpr = 32 >> sh, r = c / cpr, jp = c % cpr;
#pragma unroll
    for (int i = 0; i < 4; ++i) { const int row = 8 * (wave * 4 + i) + (lane >> 3); const int ks = 128 * jp - 64 + row; const bool ok = ks >= 0 && ks < L;
        koffs[i] = (unsigned)(b * SEQ + ((ok ? ks : 0) << sh) + r) * 4608u + (unsigned)(1536 + h * 128); }
}
__device__ __forceinline__ void attn_phase(LAS unsigned char* lds, const bf16_t* qkv, const float* relb, bf16_t* og, float* lse,
                                           int vcu, int G, int tid, int wave, int lane) {
    LAS float* bt = (LAS float*)(lds + BT_OFF);
    for (int i = tid; i < 12 * 129; i += NTHR) { const int h = i / 129, o = i % 129 - 64; const int g = h >> 2; bt[h * 160 + o + 80] = relb[t5_bucket(o * (1 << (2 * g))) * 12 + h] * 1.4426950408889634f; }
    for (int i = tid; i < 128; i += NTHR) *(LAS u32x4*)(lds + AT_V + 256 * 128 + i * 16) = (u32x4){0u, 0u, 0u, 0u};
    const int qi = lane & 15, fq = lane >> 4;
    unsigned kbase[4], vbase[8];
    {
#pragma unroll
      for (int ks = 0; ks < 4; ++ks) kbase[ks] = (unsigned)(AT_K + 2048 * wave + 128 * qi + 16 * ((2 * ks + (fq >> 1)) ^ (qi & 7)) + 8 * (fq & 1));
      const int rp = (lane & 15) >> 1, cp = lane & 1, rowl = 16 * wave + 4 * fq + (rp & 3) + ((rp >> 2) ? 16 : 0), xv = 4 * (fq & 1) + (rp & 3);
#pragma unroll
      for (int dt = 0; dt < 8; ++dt) vbase[dt] = (unsigned)(AT_V + 128 * rowl + 16 * (dt ^ xv) + 8 * cp); }
    const char* qk8 = (const char*)qkv;
#define AT_ISSUE_V(koffs) do { const int ch_ = (lane & 7) ^ (lane >> 3); _Pragma("unroll") for (int i_ = 0; i_ < 4; ++i_) \
        __builtin_amdgcn_global_load_lds((const unsigned*)(qk8 + (koffs)[i_] + 1536 + ch_ * 16), (LAS unsigned*)(lds + AT_V + (wave * 4 + i_) * 1024), 16, 0, 0); } while (0)
#define AT_ISSUE_K(koffs) do { const int ch_ = (lane & 7) ^ (lane >> 3); _Pragma("unroll") for (int i_ = 0; i_ < 4; ++i_) \
        __builtin_amdgcn_global_load_lds((const unsigned*)(qk8 + (koffs)[i_] + ch_ * 16), (LAS unsigned*)(lds + AT_K + (wave * 4 + i_) * 1024), 16, 0, 0); } while (0)
#define AT_LOADQ(u_) do { const int b_ = (u_) / 384, rem_ = (u_) % 384, h_ = rem_ >> 5, c_ = rem_ & 31, sh_ = 2 * (h_ >> 2), cpr_ = 32 >> sh_, r_ = c_ / cpr_, jp_ = c_ % cpr_; \
        const char* p_q = qk8 + ((size_t)b_ * SEQ + (size_t)((128 * jp_ + 16 * wave + qi) << sh_) + r_) * 4608 + h_ * 128 + fq * 8; \
        _Pragma("unroll") for (int ks = 0; ks < 4; ++ks) Qf[ks] = *(const long*)(p_q + 32 * ks); } while (0)
    __syncthreads();
    unsigned koffs[4]; long Qf[4];
    int u = vcu;
    if (u < NBATCH * 12 * 32) { attn_unit_rows(u, wave, lane, koffs); AT_ISSUE_K(koffs); AT_LOADQ(u); AT_ISSUE_V(koffs); }
    for (; u < NBATCH * 12 * 32; u += G) {
        const int b = u / 384, rem = u % 384, h = rem >> 5, c = rem & 31, g = h >> 2, sh = 2 * g, L = SEQ >> sh, cpr = 32 >> sh;
        const int r = c / cpr, jp = c % cpr;
        const size_t tokq = (size_t)b * SEQ + (size_t)((128 * jp + 16 * wave + qi) << sh) + r;
        const bool has_next = (u + G) < NBATCH * 12 * 32;
        asm volatile("s_waitcnt vmcnt(4)" ::: "memory"); __builtin_amdgcn_s_barrier(); asm volatile("" ::: "memory");
        f32x4 S[10];
#pragma unroll
        for (int t = 0; t < 9; ++t) { f32x4 acc = {0.f, 0.f, 0.f, 0.f};
#pragma unroll
            for (int ks = 0; ks < 4; ++ks) { const long kf = *(const LAS long*)(lds + kbase[ks] + 2048 * t); acc = __builtin_amdgcn_mfma_f32_16x16x32_fp8_fp8(kf, Qf[ks], acc, 0, 0, 0); }
            S[t] = acc; }
        S[9] = (f32x4){0.f, 0.f, 0.f, 0.f};
        const LAS float* btl = bt + h * 160 + 16 + 4 * fq - qi;
        const int d0 = 4 * fq - qi - 64, kb0 = 128 * jp - 64 + 16 * wave + 4 * fq;
        const int lob = (-64 - d0) > (-kb0) ? (-64 - d0) : (-kb0), hib = (64 - d0) < (L - 1 - kb0) ? (64 - d0) : (L - 1 - kb0);
        float mx = -3.0e38f;
#pragma unroll
        for (int t = 0; t < 9; ++t)
#pragma unroll
            for (int j = 0; j < 4; ++j) { const int e = 16 * t + j; const bool ok = e >= lob && e <= hib;
                const float sv = ok ? S[t][j] * (1.4426950408889634f / 512.0f) + btl[e] : -1.0e30f; S[t][j] = sv; mx = fmaxf(mx, sv); }
        mx = fmaxf(mx, __shfl_xor(mx, 16)); mx = fmaxf(mx, __shfl_xor(mx, 32));
        float den = 0.f; const float mx8 = mx - 8.0f;
#pragma unroll
        for (int t = 0; t < 9; ++t)
#pragma unroll
            for (int j = 0; j < 4; ++j) { const float p = __builtin_amdgcn_exp2f(S[t][j] - mx8); S[t][j] = p; den += p; }
        den += __shfl_xor(den, 16); den += __shfl_xor(den, 32); den *= (1.0f / 256.0f);
        asm volatile("s_waitcnt vmcnt(0)" ::: "memory"); __builtin_amdgcn_s_barrier(); asm volatile("" ::: "memory");
        if (has_next) { attn_unit_rows(u + G, wave, lane, koffs); AT_ISSUE_K(koffs); AT_LOADQ(u + G); }
        f32x4 O[8];
#pragma unroll
        for (int dt = 0; dt < 8; ++dt) O[dt] = (f32x4){0.f, 0.f, 0.f, 0.f};
#define PV_STEP(T) { long pf; { u32x2 pw; pw.x = pk8x4_nc(S[2 * (T)][0], S[2 * (T)][1], S[2 * (T)][2], S[2 * (T)][3]); \
                pw.y = pk8x4_nc(S[2 * (T) + 1][0], S[2 * (T) + 1][1], S[2 * (T) + 1][2], S[2 * (T) + 1][3]); pf = __builtin_bit_cast(long, pw); } \
            long vf[8]; \
            _Pragma("unroll") for (int dt = 0; dt < 8; ++dt) vf[dt] = tr8_read_off<4096 * (T)>(vbase[dt]); \
            asm volatile("s_waitcnt lgkmcnt(0)" : "+v"(vf[0]), "+v"(vf[1]), "+v"(vf[2]), "+v"(vf[3]), "+v"(vf[4]), "+v"(vf[5]), "+v"(vf[6]), "+v"(vf[7]) :: "memory"); \
            _Pragma("unroll") for (int dt = 0; dt < 8; ++dt) O[dt] = __builtin_amdgcn_mfma_f32_16x16x32_fp8_fp8(vf[dt], pf, O[dt], 0, 0, 0); }
        PV_STEP(0) PV_STEP(1) PV_STEP(2) PV_STEP(3) PV_STEP(4)
#undef PV_STEP
        const float rden = 1.0f / den;
        unsigned char* op = (unsigned char*)og + ((size_t)g * NTOK + tokq) * 512 + (h & 3) * 128 + 4 * fq;
        const float rd16 = rden * (16.0f / 2048.0f);
#pragma unroll
        for (int dt = 0; dt < 8; ++dt) *(unsigned*)(op + 16 * dt) = pk8x4(O[dt][0] * rd16, O[dt][1] * rd16, O[dt][2] * rd16, O[dt][3] * rd16);
        if (fq == 0) lse[((size_t)g * NTOK + tokq) * 4 + (h & 3)] = (mx + __builtin_amdgcn_logf(den)) * 0.6931471805599453f;
        asm volatile("s_waitcnt lgkmcnt(0)" ::: "memory"); __builtin_amdgcn_s_barrier(); asm volatile("" ::: "memory");
        if (has_next) AT_ISSUE_V(koffs);
    }
    asm volatile("s_waitcnt vmcnt(0)" ::: "memory"); __syncthreads();
#undef AT_ISSUE_K
#undef AT_ISSUE_V
#undef AT_LOADQ
}

template <int HW>
__device__ __forceinline__ void pool_item(const bf16_t* UP, bf16_t* PD, int t, int ch) {
    const int pos = t & 4095;
    const bf16_t* base = UP + (size_t)(t - pos) * 512 + ch * 8;
    u32x4 v[2 * HW];
#pragma unroll
    for (int k = 0; k < 2 * HW; ++k) { const int p = pos - HW + k; const int pc = p < 0 ? 0 : (p > 4095 ? 4095 : p); v[k] = *(const u32x4*)(base + (size_t)pc * 512); }
    float s[8];
#pragma unroll
    for (int e = 0; e < 8; ++e) s[e] = 0.f;
    int cnt = 0;
#pragma unroll
    for (int k = 0; k < 2 * HW; ++k) { const int p = pos - HW + k; const bool ok = p >= 0 && p <= 4095; const float m = ok ? 1.0f : 0.0f; cnt += ok ? 1 : 0;
        s[0] += m * bf_lo(v[k].x); s[1] += m * bf_hi(v[k].x); s[2] += m * bf_lo(v[k].y); s[3] += m * bf_hi(v[k].y); s[4] += m * bf_lo(v[k].z); s[5] += m * bf_hi(v[k].z); s[6] += m * bf_lo(v[k].w); s[7] += m * bf_hi(v[k].w); }
    const u32x4 me = v[HW];
    const float rc = 1.0f / (float)cnt;
    u32x4 w; w.x = pk2(s[0] * rc - bf_lo(me.x), s[1] * rc - bf_hi(me.x)); w.y = pk2(s[2] * rc - bf_lo(me.y), s[3] * rc - bf_hi(me.y));
    w.z = pk2(s[4] * rc - bf_lo(me.z), s[5] * rc - bf_hi(me.z)); w.w = pk2(s[6] * rc - bf_lo(me.w), s[7] * rc - bf_hi(me.w));
    *(u32x4*)(PD + (size_t)t * 512 + ch * 8) = w;
}
__device__ __forceinline__ void pool_phase(const bf16_t* UP, bf16_t* PD, int vcu, int G, int wave, int lane) {
    const int gw = vcu * NWAVES + wave, NGW = G * NWAVES;
    for (int it = gw; it < (NTOK / 4) * 4; it += NGW) {
        const int g = it & 3, t = (it >> 2) * 4 + (lane >> 4), ch = g * 16 + (lane & 15);
        if (g == 0) pool_item<1>(UP, PD, t, ch); else if (g == 1) pool_item<2>(UP, PD, t, ch); else if (g == 2) pool_item<4>(UP, PD, t, ch); else pool_item<8>(UP, PD, t, ch);
    }
}
__device__ __forceinline__ void combine_phase(const bf16_t* og, const float* lse, bf16_t* ATTN, int vcu, int G, int tid) {
    const int nthr = G * NTHR;
    int z; asm volatile("v_mov_b32 %0, 0" : "=v"(z));
    for (int id = vcu * NTHR + tid + z; id < NTOK * 64; id += nthr) {
        const int t = id >> 6, ch = id & 63, hs = ch >> 4;
        const float l0 = lse[((size_t)0 * NTOK + t) * 4 + hs], l1 = lse[((size_t)1 * NTOK + t) * 4 + hs], l2 = lse[((size_t)2 * NTOK + t) * 4 + hs];
        const float m = fmaxf(l0, fmaxf(l1, l2)); float w0 = __expf(l0 - m), w1 = __expf(l1 - m), w2 = __expf(l2 - m); const float rs = 1.0f / (w0 + w1 + w2); w0 *= rs; w1 *= rs; w2 *= rs;
        const unsigned char* o8 = (const unsigned char*)og + (size_t)t * 512 + ch * 8;
        const u32x2 a = *(const u32x2*)o8, bq = *(const u32x2*)(o8 + (size_t)NTOK * 512), cq = *(const u32x2*)(o8 + (size_t)2 * NTOK * 512);
        w0 *= 0.0625f; w1 *= 0.0625f; w2 *= 0.0625f;
        const f32x2 a0 = __builtin_amdgcn_cvt_pk_f32_fp8((int)a.x, false), a1 = __builtin_amdgcn_cvt_pk_f32_fp8((int)a.x, true), a2 = __builtin_amdgcn_cvt_pk_f32_fp8((int)a.y, false), a3 = __builtin_amdgcn_cvt_pk_f32_fp8((int)a.y, true);
        const f32x2 b0 = __builtin_amdgcn_cvt_pk_f32_fp8((int)bq.x, false), b1 = __builtin_amdgcn_cvt_pk_f32_fp8((int)bq.x, true), b2 = __builtin_amdgcn_cvt_pk_f32_fp8((int)bq.y, false), b3 = __builtin_amdgcn_cvt_pk_f32_fp8((int)bq.y, true);
        const f32x2 c0 = __builtin_amdgcn_cvt_pk_f32_fp8((int)cq.x, false), c1 = __builtin_amdgcn_cvt_pk_f32_fp8((int)cq.x, true), c2 = __builtin_amdgcn_cvt_pk_f32_fp8((int)cq.y, false), c3 = __builtin_amdgcn_cvt_pk_f32_fp8((int)cq.y, true);
        const f32x2 r0 = a0 * w0 + b0 * w1 + c0 * w2, r1 = a1 * w0 + b1 * w1 + c1 * w2, r2 = a2 * w0 + b2 * w1 + c2 * w2, r3 = a3 * w0 + b3 * w1 + c3 * w2;
        u32x4 w; w.x = pk2(r0.x, r0.y); w.y = pk2(r1.x, r1.y); w.z = pk2(r2.x, r2.y); w.w = pk2(r3.x, r3.y);
        *(u32x4*)(ATTN + (size_t)t * 512 + ch * 8) = w;
    }
}

__device__ __forceinline__ void dft_combine_phase(const bf16_t* P, const float* T, const unsigned char* Ytf, bf16_t* FOUR, int vcu, int G, int tid, int wave, int lane) {
    const int nthr = G * NTHR;
    int z; asm volatile("v_mov_b32 %0, 0" : "=v"(z));
    for (int id = vcu * NTHR + tid + z; id < NBATCH * 2048 * 64; id += nthr) {
        const int ch = id & 63, k1 = (id >> 6) & 2047, b = id >> 17;
        const bf16_t* p1 = P + ((size_t)(b * 2048 + k1)) * 512 + ch * 8; const bf16_t* p2 = p1 + (size_t)8 * 2048 * 512;
        const u32x4 pa = *(const u32x4*)p1, pb = *(const u32x4*)p2;
        const f32x4 a0 = {bf_lo(pa.x), bf_hi(pa.x), bf_lo(pa.y), bf_hi(pa.y)}, a1 = {bf_lo(pa.z), bf_hi(pa.z), bf_lo(pa.w), bf_hi(pa.w)}, b0 = {bf_lo(pb.x), bf_hi(pb.x), bf_lo(pb.y), bf_hi(pb.y)}, b1 = {bf_lo(pb.z), bf_hi(pb.z), bf_lo(pb.w), bf_hi(pb.w)};
        const float sg = (k1 & 1) ? -0.015625f : 0.015625f;
        const f32x4 t0 = *(const f32x4*)(T + b * 512 + ch * 8) * sg, t1 = *(const f32x4*)(T + b * 512 + ch * 8 + 4) * sg;
        { const f32x4 v0 = a0 + b0 + t0, v1 = a1 + b1 + t1; u32x4 w; w.x = pk2(v0[0], v0[1]); w.y = pk2(v0[2], v0[3]); w.z = pk2(v1[0], v1[1]); w.w = pk2(v1[2], v1[3]);
          *(u32x4*)(FOUR + ((size_t)b * SEQ + k1) * 512 + ch * 8) = w; }
        if (k1 > 0) { const f32x4 v0 = a0 - b0 + t0, v1 = a1 - b1 + t1; u32x4 w; w.x = pk2(v0[0], v0[1]); w.y = pk2(v0[2], v0[3]); w.z = pk2(v1[0], v1[1]); w.w = pk2(v1[2], v1[3]);
          *(u32x4*)(FOUR + ((size_t)b * SEQ + SEQ - k1) * 512 + ch * 8) = w; }
    }
    const int gw = vcu * NWAVES + wave, NGW = G * NWAVES;
    for (int idx = gw; idx < NBATCH * 512; idx += NGW) {
        const u32x4* yp = (const u32x4*)(Ytf + (size_t)idx * 4096) + lane; float s = 0.f;
#pragma unroll
        for (int q = 0; q < 2; ++q) { const u32x4 y = yp[64 * q]; const unsigned yw[4] = {y.x, y.y, y.z, y.w};
#pragma unroll
            for (int e = 0; e < 4; ++e) { const f32x2 lo = __builtin_amdgcn_cvt_pk_f32_fp8((int)yw[e], false), hi = __builtin_amdgcn_cvt_pk_f32_fp8((int)yw[e], true); s += (lo[0] - lo[1]) + (hi[0] - hi[1]); } }
        s = wave_sum(s) * (1.0f / DFT_SY);
        if (lane == 0) { const float v = (s + T[idx]) * 0.015625f; FOUR[((size_t)(idx >> 9) * SEQ + 2048) * 512 + (idx & 511)] = (bf16_t)(pk2(v, 0.f) & 0xffffu); }
    }
}

constexpr int NSTEPS = 42;
#if ONE_LAUNCH
#define GRID_BAR() xcd_barrier(bar)
#else
#define GRID_BAR() do {} while (0)
#endif
#ifndef PHMASK
#define PHMASK 0xFFFFFFFFu
#endif
#ifndef SUBREP_A
#define SUBREP_A 0
#define SUBREP_B 0
#define SUBREP_C 0
#endif
#ifndef REPMASK
#define REPMASK 0u
#endif
#define REPS(k) (1 + (int)((REPMASK >> (k)) & 1u))
#define IN(k) (lo <= (k) && (k) < hi)
#ifndef BAR_REPS
#define BAR_REPS 1
#endif
#define SEAM(k) do { if (IN((k) + 1)) { for (int br_ = 0; br_ < BAR_REPS; ++br_) GRID_BAR(); } } while (0)
#define PHASE_BEGIN() const __attribute__((address_space(4))) Args* ap = (const __attribute__((address_space(4))) Args*)__builtin_amdgcn_kernarg_segment_ptr(); asm volatile("" : "+s"(ap)); const Args args = load_args(ap); \
    int G = G0, bx = bx0, vcu = vcu0; asm volatile("" : "+s"(G), "+s"(bx), "+s"(vcu)); (void)bx; \
    int tid = tid0; asm volatile("" : "+v"(tid)); const int lane = tid & 63; const int wave = __builtin_amdgcn_readfirstlane(tid >> 6); (void)lane; (void)wave; \
    unsigned char* ws = args.ws; unsigned* ctl = (unsigned*)(ws + WS_CTL); (void)ctl; bf16_t* const H = (bf16_t*)(ws + WS_H); (void)H; bf16_t* const X = (bf16_t*)(ws + WS_XB); (void)X; unsigned char* const OUTB = (unsigned char*)args.out; (void)OUTB; u32x2* const RINFO = (u32x2*)(ws + WS_RINFO); (void)RINFO;

template <int l>
__device__ __forceinline__ void run_layer(LAS unsigned char* lds, const int tid0, const int G0, const int bx0, const int vcu0, const int lo, const int hi, const XcdBarrier& bar) {
        constexpr int s0 = 1 + 10 * l; constexpr bool moe = (l & 1) != 0; constexpr int jj = l >> 1;
        if ((PHMASK & 2u) && IN(s0 + 0)) { for (int rep_ = 0; rep_ < REPS(1); ++rep_) { PHASE_BEGIN(); asm volatile("; ==PH 1");
            const float* gain = args.in[I_NMG] + l * DM;
            bf16_t* const HF = (bf16_t*)(ws + WS_HF); signed char* const H8 = (signed char*)(ws + WS_H); float* const SH = (float*)(ws + WS_H + H_SH);
            if constexpr (l == 0) norm1_pair_phase<false>(args.in[I_X], nullptr, nullptr, gain, H8, SH, HF, vcu, G, wave, lane);
            else if constexpr (l == 2) norm1_pair_phase<true>(X, (const bf16_t*)(ws + WS_Y1), X, gain, H8, SH, HF, vcu, G, wave, lane);
            else norm1_pair_phase<true>(X, nullptr, nullptr, gain, H8, SH, HF, vcu, G, wave, lane);
            }
            SEAM(s0 + 0);
        }
        if ((PHMASK & 4u) && IN(s0 + 1)) { for (int rep_ = 0; rep_ < REPS(2); ++rep_) { PHASE_BEGIN(); asm volatile("; ==PH 2");
            const char* WINl = (const char*)(ws + WS_WIN + (size_t)l * WIN_SLOT);
            { pg8::SchedIn S; S.tm.init(NTOK / 256, 32, G, bx); S.A = (const char*)H; S.Bt = WINl;
              pg8::EpiIn E{(bf16_t*)(ws + WS_QKV), (bf16_t*)(ws + WS_UP), (bf16_t*)(ws + WS_GATES), args.in[I_QG] + l * 128, args.in[I_KG] + l * 128, (LAS float*)(lds + 131072), (const float*)(ws + WS_H + H_SH), (const float*)(WINl + WIN_SW)};
              pg8::gemm_phase<pg8::EpiIn, pg8::SchedIn, 1024, 1024, 1024, false, 2>(lds, S, E, tid); }
            { pg8::SchedFour S; S.A = (const char*)(ws + WS_HF); S.Bt = WINl + WIN_F; S.G = G; S.c = bx;
              pg8::EpiYtf E{(unsigned char*)(ws + WS_YT)};
              pg8::gemm_phase<pg8::EpiYtf, pg8::SchedFour, 1024, 1024, 1024, true>(lds, S, E, tid); }
            }
            SEAM(s0 + 1);
        }
        if ((PHMASK & 8u) && IN(s0 + 2)) { for (int rep_ = 0; rep_ < REPS(3); ++rep_) { PHASE_BEGIN(); asm volatile("; ==PH 3");
            { pg8::SchedDFT S; S.DS = (const char*)(ws + WS_DS); S.Yt = (const char*)(ws + WS_YT); S.G = G; S.c = bx;
              pg8::EpiDFT E{(bf16_t*)(ws + WS_SLAB)};
              pg8::gemm_phase<pg8::EpiDFT, pg8::SchedDFT, 2048, 4096, 4096, false, 1>(lds, S, E, tid); }
            __syncthreads();
            { int tid2 = tid; asm volatile("" : "+v"(tid2)); const int lane2 = tid2 & 63, wave2 = __builtin_amdgcn_readfirstlane(tid2 >> 6);
              attn_phase(lds, (const bf16_t*)(ws + WS_QKV), args.in[I_RELB], (bf16_t*)(ws + WS_OG), (float*)(ws + WS_LSE), vcu, G, tid2, wave2, lane2);
              t2048_phase((const signed char*)(ws + WS_H), (const float*)(ws + WS_H + H_SH), (const bf16_t*)(ws + WS_WIN + (size_t)l * WIN_SLOT + WIN_F), (float*)(ws + WS_T2048), vcu, G, wave2, lane2);
              pool_phase((const bf16_t*)(ws + WS_UP), (bf16_t*)(ws + WS_PD), vcu, G, wave2, lane2); }
            }
            SEAM(s0 + 2);
        }
        if ((PHMASK & 16u) && IN(s0 + 3)) { PHASE_BEGIN(); asm volatile("; ==PH 4");
            combine_phase((const bf16_t*)(ws + WS_OG), (const float*)(ws + WS_LSE), (bf16_t*)(ws + WS_ATTN), vcu, G, tid);
            dft_combine_phase((const bf16_t*)(ws + WS_SLAB), (const float*)(ws + WS_T2048), (const unsigned char*)(ws + WS_YT), (bf16_t*)(ws + WS_FOUR), vcu, G, tid, wave, lane);
            SEAM(s0 + 3);
        }
        if ((PHMASK & 32u) && IN(s0 + 5)) { for (int rep_ = 0; rep_ < REPS(5); ++rep_) { PHASE_BEGIN(); asm volatile("; ==PH 5");
            pg8::SchedBranch S; S.tm.init(NTOK / 256, 4, G, bx); S.ws = (const char*)ws;
            S.W = (const char*)((const bf16_t*)(ws + WS_WB) + (size_t)l * 3 * 1024 * 512);
            pg8::EpiBranch E{(const unsigned char*)(ws + WS_GATES), (bf16_t*)(ws + WS_MERGED)};
            pg8::gemm_phase<pg8::EpiBranch, pg8::SchedBranch, 512, 512, 512>(lds, S, E, tid);
            }
            SEAM(s0 + 5);
        }
        if ((PHMASK & 64u) && IN(s0 + 6)) { for (int rep_ = 0; rep_ < REPS(6); ++rep_) { PHASE_BEGIN(); asm volatile("; ==PH 6");
            pg8::SchedPlain S; S.init((const bf16_t*)(ws + WS_MERGED), 1024, (const bf16_t*)(ws + WS_WO) + (size_t)l * 1024 * 1024, 1024, NTOK, 1024, G, bx);
            pg8::EpiRes<l != 0> E{l == 0 ? (const void*)args.in[I_X] : (const void*)X, X, 1.0f};
            pg8::gemm_phase<pg8::EpiRes<l != 0>, pg8::SchedPlain, 1024, 1024, 1024>(lds, S, E, tid);
            }
            SEAM(s0 + 6);
        }
        constexpr bool f8 = moe && ((MOE_F8_MASK >> jj) & 1) != 0; constexpr bool f8d = !moe && ((DENSE_F8_MASK >> jj) & 1) != 0; constexpr bool i8d = !moe && ((DENSE_UP8_MASK >> jj) & 1) != 0;
        if ((PHMASK & 128u) && IN(s0 + 7)) { for (int rep_ = 0; rep_ < REPS(7); ++rep_) { PHASE_BEGIN(); asm volatile("; ==PH 7");
            const float* gain = args.in[I_NFG] + l * DM;
            if constexpr (!moe) norm_phase<i8d ? 2 : (f8d ? 1 : 0)>(X, gain, H, (float*)(ws + WS_H + H_SH), vcu, G, wave, lane);
            else {
                norm_router_phase<f8>(X, gain, args.in[I_RW] + (size_t)jj * 1024 * 8, args.in[I_RB] + jj * 8, H, ctl + CW_GCNT + jj * 16, RINFO, (unsigned long long*)(ctl + CW_GRAN) + jj * 2048, (unsigned)jj + 1u, lds, vcu, G, tid, wave, lane);
                LAS float* scr = (LAS float*)(lds + wave * 16384);
                const int gw = vcu * NWAVES + wave, NGW = G * NWAVES;
                const float* mw1 = args.in[I_MW1] + (size_t)jj * 8 * 1024 * ED; const float* mw3 = args.in[I_MW3] + (size_t)jj * 8 * 1024 * ED;
                for (int sr_ = 0; sr_ < 1 + SUBREP_C; ++sr_)
                if constexpr (f8) {
                    cvt_w13_8(mw1, mw3, ED, 8, OUTB, F8_SW, scr, gw, NGW, lane);
                    for (int e = 0; e < 8; ++e) cvt_plain8(args.in[I_MW2] + ((size_t)jj * 8 + e) * ED * 1024, 1024, ED, (unsigned char*)(ws + WS_WM2) + (size_t)e * 1024 * ED, 1024, F8_SW, scr, gw, NGW, lane);
                } else {
                    cvt_w13(mw1, mw3, ED, 8, (bf16_t*)OUTB, scr, gw, NGW, lane);
                    for (int e = 0; e < 8; ++e) cvt_plain(args.in[I_MW2] + ((size_t)jj * 8 + e) * ED * 1024, 1024, ED, (bf16_t*)(ws + WS_WM2) + (size_t)e * 1024 * ED, 0, 1024, 0, scr, gw, NGW, lane);
                }
            }
            }
            SEAM(s0 + 7);
        }
        if ((PHMASK & 256u) && IN(s0 + 8)) { for (int rep_ = 0; rep_ < REPS(8); ++rep_) { PHASE_BEGIN(); asm volatile("; ==PH 8");
            if constexpr (!moe) {
                pg8::SchedPlain S; S.init(H, 1024, (const void*)(ws + WS_W13 + (size_t)jj * W13_SLOT), 1024, NTOK, 2 * FF, G, bx, (f8d || i8d) ? 1 : 2);
                pg8::EpiSwiglu<f8d, i8d> E{(void*)(ws + WS_ACT), FF, f8d ? 1.0f / F8_SW : 1.0f, f8d ? F8_SACT : 1.0f, (const float*)(ws + WS_H + H_SH), (const float*)(ws + WS_W13 + (size_t)jj * W13_SLOT + W13_SW)};
                pg8::gemm_phase<pg8::EpiSwiglu<f8d, i8d>, pg8::SchedPlain, 1024, 1024, 1024, false, i8d ? 2 : (f8d ? 1 : 0)>(lds, S, E, tid);
            } else {
                pg8::moe_tiles_setup((LAS int*)(lds + MISC_OFF + 3328), ctl + CW_GCNT + jj * 16, tid);
                pg8::SchedMoeUp<f8 ? 1 : 2> S; S.mt.t = (const LAS int*)(lds + MISC_OFF + 3328); S.tm.init(S.mt.total(), 28, G, bx); S.H = (const char*)H; S.W13 = (const char*)OUTB; S.rinfo = RINFO;
                pg8::EpiSwiglu<f8> E{(void*)(ws + WS_ACT), ED, f8 ? 1.0f / F8_SW : 1.0f, f8 ? F8_SACT : 1.0f, nullptr, nullptr};
                pg8::gemm_phase<pg8::EpiSwiglu<f8>, pg8::SchedMoeUp<f8 ? 1 : 2>, 1024, 1024, 1024, false, f8 ? 1 : 0>(lds, S, E, tid);
            }
            }
            SEAM(s0 + 8);
        }
        if ((PHMASK & 512u) && IN(s0 + 9)) { for (int rep_ = 0; rep_ < REPS(9); ++rep_) { PHASE_BEGIN(); asm volatile("; ==PH 9");
            if constexpr (!moe) {
                pg8::SchedPlain S; S.init((const bf16_t*)(ws + WS_ACT), FF, (const bf16_t*)(ws + WS_W2) + (size_t)jj * 1024 * FF, FF, NTOK, 1024, G, bx, f8d ? 1 : 2);
                pg8::EpiRes<true> E{X, X, f8d ? 1.0f / (F8_SW * F8_SACT) : 1.0f};
                pg8::gemm_phase<pg8::EpiRes<true>, pg8::SchedPlain, FF, FF, FF, false, f8d ? 1 : 0>(lds, S, E, tid);
            } else {
                pg8::moe_tiles_setup((LAS int*)(lds + MISC_OFF + 3328), ctl + CW_GCNT + jj * 16, tid);
                pg8::SchedMoeDown<f8 ? 1 : 2> S; S.mt.t = (const LAS int*)(lds + MISC_OFF + 3328); S.tm.init(S.mt.total(), 4, G, bx); S.ACT = (const char*)(ws + WS_ACT); S.W2 = (const char*)(ws + WS_WM2);
                const int nwg_ = S.mt.total() * 4; int lim_ = (nwg_ / G) * G, ntail_ = nwg_ - lim_; if (lim_ == 0 || ntail_ > MOE_TAIL_MAX) { lim_ = nwg_; ntail_ = 0; }
                S.lim = lim_;
                pg8::EpiMoeDown E{X, (bf16_t*)(ws + WS_Y1), RINFO, S.mt, f8 ? 1.0f / (F8_SW * F8_SACT) : 1.0f};
                pg8::gemm_phase<pg8::EpiMoeDown, pg8::SchedMoeDown<f8 ? 1 : 2>, ED, ED, ED, false, f8 ? 1 : 0>(lds, S, E, tid);
                if (ntail_ > 0) {
                    pg8::SchedMoeDownTail<f8 ? 1 : 2, MOE_KS> ST; ST.tm = S.tm; ST.mt = S.mt; ST.ACT = S.ACT; ST.W2 = S.W2; ST.lim = lim_; ST.ntail = ntail_;
                    pg8::EpiMoeDownTail<MOE_KS> ET{E, (float*)OUTB, ctl + CW_TAIL + jj * 64, (LAS int*)(lds + MISC_OFF + 3328) + 31};
                    pg8::gemm_phase<pg8::EpiMoeDownTail<MOE_KS>, pg8::SchedMoeDownTail<f8 ? 1 : 2, MOE_KS>, ED / MOE_KS, ED, ED, false, f8 ? 1 : 0>(lds, ST, ET, tid);
                }
            }
            }
            SEAM(s0 + 9);
        }
    }

__global__ void __launch_bounds__(NTHR, 2) fwd_kernel(Args args_by_value) {
    extern __shared__ __attribute__((aligned(16))) unsigned char lds_raw[];
    LAS unsigned char* lds = (LAS unsigned char*)lds_raw;
    const int tid0 = threadIdx.x;
    const int G0 = gridDim.x; const int bx0 = blockIdx.x; const int vcu0 = (G0 % 8 == 0) ? (bx0 % 8) * (G0 / 8) + bx0 / 8 : bx0;
    volatile LAS unsigned* MISC = (volatile LAS unsigned*)(lds + MISC_OFF);
    if (tid0 < 16) MISC[tid0] = 0u;
    __syncthreads();
#if ONE_LAUNCH
    XcdBarrier bar = xcd_barrier_post((unsigned*)(args_by_value.ws + WS_CTL) + CW_BAR, MISC);
#else
    XcdBarrier bar; bar.bar = nullptr; bar.x = 0; bar.st = MISC;
#endif
    const int lo = args_by_value.ph_lo, hi = args_by_value.ph_hi;
    if ((PHMASK & 1u) && IN(0)) { for (int rep_ = 0; rep_ < REPS(0); ++rep_) { PHASE_BEGIN(); asm volatile("; ==PH 0"); prologue_phase(args, lds, vcu, G, tid, wave, lane); __syncthreads(); }   }
    run_layer<0>(lds, tid0, G0, bx0, vcu0, lo, hi, bar);
    run_layer<1>(lds, tid0, G0, bx0, vcu0, lo, hi, bar);
    run_layer<2>(lds, tid0, G0, bx0, vcu0, lo, hi, bar);
    run_layer<3>(lds, tid0, G0, bx0, vcu0, lo, hi, bar);
    if ((PHMASK & 1024u) && IN(41)) { PHASE_BEGIN(); add_phase(args.out, X, (const bf16_t*)(ws + WS_Y1), vcu, G, tid); }
#undef IN
#undef SEAM
}

extern "C" void kernel_launch(void* const* d_in, const int* in_sizes, int n_in, void* d_out, int out_size, void* d_ws, size_t ws_size, hipStream_t stream) {
    static int grid = 0;
    if (grid == 0) {
        if (n_in != 21 || in_sizes[0] != NTOK * DM || out_size != NTOK * DM || ws_size < WS_END) {
            fprintf(stderr, "kernel_launch: unexpected problem (n_in %d, in0 %d, out %d, ws %zu < %zu?); nothing launched\n", n_in, n_in > 0 ? in_sizes[0] : -1, out_size, ws_size, (size_t)WS_END); grid = -1; return; }
        int dev = 0, cus = 0, per_cu = 0;
        if (hipGetDevice(&dev) != hipSuccess || hipDeviceGetAttribute(&cus, hipDeviceAttributeMultiprocessorCount, dev) != hipSuccess) { grid = -1; return; }
        if (hipFuncSetAttribute((const void*)fwd_kernel, hipFuncAttributeMaxDynamicSharedMemorySize, LDS_BYTES) != hipSuccess) { fprintf(stderr, "kernel_launch: hipFuncSetAttribute failed\n"); grid = -1; return; }
        if (hipOccupancyMaxActiveBlocksPerMultiprocessor(&per_cu, (const void*)fwd_kernel, NTHR, LDS_BYTES) != hipSuccess || per_cu < 1) { fprintf(stderr, "kernel_launch: occupancy query reports %d\n", per_cu); }
        (void)hipGetLastError();
        grid = cus;
    }
    if (grid < 0) return;
    (void)hipMemsetAsync((char*)d_ws + WS_CTL, 0, CTL_ZERO_BYTES, stream);
    Args a{};
    for (int i = 0; i < 21; ++i) a.in[i] = (const float*)d_in[i];
    a.out = (float*)d_out; a.ws = (unsigned char*)d_ws;
#if ONE_LAUNCH
    a.ph_lo = 0; a.ph_hi = NSTEPS;
    hipLaunchKernelGGL(fwd_kernel, dim3(grid), dim3(NTHR), LDS_BYTES, stream, a);
#else
    for (int s = 0; s < NSTEPS; ++s) { a.ph_lo = s; a.ph_hi = s + 1; hipLaunchKernelGGL(fwd_kernel, dim3(grid), dim3(NTHR), LDS_BYTES, stream, a); }
#endif
}
```
